# Optimizing an MI355X kernel written in HIP

```python
import jax
import jax.numpy as jnp
from jax import lax
import numpy as np

D_MODEL = 1024
BATCH = 8
SEQ = 4096
DEPTH = 1

CTX_LEN = 256
GRID_W = 64

RW_HEADS = 8
RW_HEAD_DIM = 64
RW_WIDTH = RW_HEADS * RW_HEAD_DIM
RW_DECAY_RANK = 64
RW_ICLR_RANK = 64
RW_GATE_RANK = 128
RW_GN_EPS = 64e-5
RW_COLS = 3 * RW_WIDTH + 2 * RW_DECAY_RANK + 2 * RW_ICLR_RANK + RW_GATE_RANK
RW_SPLITS = tuple(int(i) for i in np.cumsum([RW_WIDTH] * 3 + [RW_DECAY_RANK] * 2 + [RW_ICLR_RANK] * 2))

GLA_HEADS = 4
GLA_KEY_DIM = 64
GLA_VAL_DIM = 128
GLA_QK_WIDTH = GLA_HEADS * GLA_KEY_DIM
GLA_WIDTH = GLA_HEADS * GLA_VAL_DIM
GLA_GATE_RANK = 16
GLA_GATE_TAU = 16.0
GLA_CHUNK = 64
GLA_SUBCHUNK = 16
GLA_NORM_EPS = 1e-5
GLA_COLS = 2 * GLA_QK_WIDTH + GLA_WIDTH + 2 * GLA_GATE_RANK + GLA_WIDTH
GLA_SPLITS = tuple(int(i) for i in np.cumsum([GLA_QK_WIDTH] * 2 + [GLA_WIDTH] + [GLA_GATE_RANK] * 2))

MIX_WIDTH = RW_WIDTH + GLA_WIDTH
N_IN = RW_COLS + GLA_COLS
FFN_HIDDEN = ((-(-8 * D_MODEL // 3)) + 255) // 256 * 256
NORM_EPS = 1e-6

kernel_name = "hybrid_rwkv7_gla_dit_block"


def _rmsnorm(x, g):
    xf = x.astype(jnp.float32)
    y = xf * lax.rsqrt(jnp.mean(xf * xf, axis=-1, keepdims=True) + NORM_EPS)
    return (y * g.astype(jnp.float32)).astype(x.dtype)


def _modulate(h, shift, scale):
    return h * (1 + scale) + shift


def _swiglu(u, w_in, w_out):
    gate, up = jnp.split(u @ w_in, 2, axis=-1)
    return (jax.nn.silu(gate) * up) @ w_out


def _grid_transpose(t, a, b):
    B = t.shape[0]
    return t.reshape((B, a, b) + t.shape[2:]).swapaxes(1, 2).reshape(t.shape)


def _qshift_grid(p, rows):
    B, T, C = p.shape
    p5 = p.reshape(B, rows, GRID_W, C // 4, 4)
    zc = jnp.zeros_like(p5[:, :, :1, :, 0])
    zr = jnp.zeros_like(p5[:, :1, :, :, 0])
    left = jnp.concatenate([zc, p5[:, :, :-1, :, 0]], axis=2)
    right = jnp.concatenate([p5[:, :, 1:, :, 1], zc], axis=2)
    up = jnp.concatenate([zr, p5[:, :-1, :, :, 2]], axis=1)
    down = jnp.concatenate([p5[:, 1:, :, :, 3], zr], axis=1)
    return jnp.stack([left, right, up, down], axis=-1).reshape(B, T, C)


def _qshift_seq(p):
    B, T, C = p.shape
    p4 = p.reshape(B, T, C // 4, 4)
    z = jnp.zeros_like(p4[:, :1])
    prev = jnp.concatenate([z, p4[:, :-1]], axis=1)
    nxt = jnp.concatenate([p4[:, 1:], z], axis=1)
    even = (jnp.arange(4) % 2) == 0
    return jnp.where(even, prev, nxt).reshape(B, T, C)


def _rwkv_inputs(p, p_shift, mu, w0, w2, a0, a2, k_k, k_a):
    xm = p + (p_shift - p) * mu
    r, k, v, lw_f, lw_b, la_f, la_b, lg = jnp.split(xm, RW_SPLITS, axis=-1)
    B, T, _ = p.shape
    heads = lambda t: t.reshape(B, T, RW_HEADS, RW_HEAD_DIM)
    kk = heads((k * k_k).astype(jnp.float32))
    kk = kk / jnp.maximum(jnp.linalg.norm(kk, axis=-1, keepdims=True), 1e-12)
    w_dirs, k_dirs, a_dirs = [], [], []
    for d, (lw, la) in enumerate(((lw_f, la_f), (lw_b, la_b))):
        w_raw = -jax.nn.softplus(-(w0[d] + jnp.tanh(lw) @ w2[d])) - 0.5
        w_dirs.append(heads(jnp.exp(-jnp.exp(w_raw.astype(jnp.float32)))))
        a = jax.nn.sigmoid(a0[d] + la @ a2[d])
        k_dirs.append(heads(k * (1 + (a - 1) * k_a)))
        a_dirs.append(heads(a))
    return dict(r=heads(r), v=heads(v), kk=kk, lg=lg, w=w_dirs, k=k_dirs, a=a_dirs)


def _rwkv7_scan(s0, r, w, k, v, kk, a, reverse, emit):
    xs = tuple(jnp.moveaxis(t.astype(jnp.float32), 1, 0) for t in (r, w, k, v, kk, a))

    def step(s, inp):
        r_t, w_t, k_t, v_t, kk_t, a_t = inp
        sa = jnp.einsum('bhvk,bhk->bhv', s, -kk_t)
        s = (s * w_t[:, :, None, :] + sa[..., None] * (kk_t * a_t)[:, :, None, :]
             + v_t[..., None] * k_t[:, :, None, :])
        return s, (jnp.einsum('bhvk,bhk->bhv', s, r_t) if emit else None)

    s, ys = lax.scan(step, s0, xs, reverse=reverse)
    return s, (jnp.moveaxis(ys, 0, 1) if emit else None)


def _rwkv_output(y, f, r_k, ln_w, ln_b, g2):
    B, T = y.shape[:2]
    mean = jnp.mean(y, axis=-1, keepdims=True)
    var = jnp.mean(jnp.square(y - mean), axis=-1, keepdims=True)
    yn = ((y - mean) * lax.rsqrt(var + RW_GN_EPS)).reshape(B, T, RW_WIDTH) * ln_w + ln_b
    bonus = jnp.sum(f['r'] * (f['k'][0] + f['k'][1]) * r_k, axis=-1, keepdims=True) * f['v']
    g = jax.nn.sigmoid(f['lg']) @ g2
    return (yn + bonus.reshape(B, T, RW_WIDTH)) * g


def _gla_inputs(p, a2, ab):
    q, k, v, lf, lb, og = jnp.split(p, GLA_SPLITS, axis=-1)
    B, T, _ = p.shape
    hk = lambda t: t.reshape(B, T, GLA_HEADS, GLA_KEY_DIM)
    log_a = [hk(jax.nn.log_sigmoid((lr @ a2[d] + ab[d]).astype(jnp.float32)) / GLA_GATE_TAU)
             for d, lr in enumerate((lf, lb))]
    return dict(q=hk(q * GLA_KEY_DIM ** -0.5), k=hk(k),
                v=v.reshape(B, T, GLA_HEADS, GLA_VAL_DIM), log_a=log_a, og=og)


def _gla_intra(q, k, b):
    B, H, C, DK = q.shape
    L = GLA_SUBCHUNK
    S = C // L
    qs, ks, bs = (t.reshape(B, H, S, L, DK) for t in (q, k, b))
    causal = jnp.tril(jnp.ones((L, L), bool))
    diff = bs[:, :, :, :, None, :] - bs[:, :, :, None, :, :]
    decay = jnp.exp(jnp.where(causal[:, :, None], diff, -jnp.inf))
    a_diag = jnp.einsum('bhsid,bhsjd,bhsijd->bhsij', qs, ks, decay)
    e = bs[:, :, :, -1, :]
    earlier = jnp.arange(S)[:, None] > jnp.arange(S)[None, :]
    q_exp = jnp.where(earlier[:, :, None, None],
                      bs[:, :, :, None] - e[:, :, None, :, None, :], -jnp.inf)
    q_off = qs[:, :, :, None] * jnp.exp(q_exp)
    k_off = ks * jnp.exp(e[:, :, :, None, :] - bs)
    a_off = jnp.einsum('bhpsid,bhsjd->bhpsij', q_off, k_off)
    a_blk = a_off + jnp.eye(S, dtype=a_off.dtype)[:, :, None, None] * a_diag[:, :, :, None]
    return a_blk.transpose(0, 1, 2, 4, 3, 5).reshape(B, H, C, C)


def _gla_scan(s0, q, k, v, log_a, reverse, emit):
    if reverse:
        q, k, v, log_a = (jnp.flip(t, axis=1) for t in (q, k, v, log_a))
    B, T, H, _ = k.shape
    n = T // GLA_CHUNK

    def chunks(t):
        t = t.astype(jnp.float32).reshape(B, n, GLA_CHUNK, H, t.shape[-1])
        return t.transpose(1, 0, 3, 2, 4)

    def step(s, inp):
        qc, kc, vc, gc = inp
        b = jnp.cumsum(gc, axis=2)
        b_last = b[:, :, -1:, :]
        o = None
        if emit:
            o = (jnp.einsum('bhcd,bhde->bhce', qc * jnp.exp(b), s)
                 + jnp.einsum('bhij,bhje->bhie', _gla_intra(qc, kc, b), vc))
        s = (jnp.exp(b_last[:, :, 0, :, None]) * s
             + jnp.einsum('bhcd,bhce->bhde', kc * jnp.exp(b_last - b), vc))
        return s, o

    s, o = lax.scan(step, s0, tuple(chunks(t) for t in (q, k, v, log_a)))
    if not emit:
        return s, None
    o = o.transpose(1, 0, 3, 2, 4).reshape(B, T, H, GLA_VAL_DIM)
    return s, (jnp.flip(o, axis=1) if reverse else o)


def _gla_output(o, og, gain):
    B, T = og.shape[:2]
    on = o * lax.rsqrt(jnp.mean(o * o, axis=-1, keepdims=True) + GLA_NORM_EPS) * gain.astype(jnp.float32)
    return on.reshape(B, T, GLA_WIDTH) * jax.nn.silu(og.astype(jnp.float32))


def _token_mixers(p_ctx, p_lat, rows, emit_ctx, mu, w0, w2, a0, a2, g2, k_k, k_a, r_k, ln_w, ln_b,
                  gla_a2, gla_ab, gla_g):
    B = p_lat.shape[0]
    pr_c, pg_c = p_ctx[..., :RW_COLS], p_ctx[..., RW_COLS:]
    pr_l, pg_l = p_lat[..., :RW_COLS], p_lat[..., RW_COLS:]

    fc = _rwkv_inputs(pr_c, _qshift_seq(pr_c), mu, w0, w2, a0, a2, k_k, k_a)
    fl = _rwkv_inputs(pr_l, _qshift_grid(pr_l, rows), mu, w0, w2, a0, a2, k_k, k_a)
    s0 = jnp.zeros((B, RW_HEADS, RW_HEAD_DIM, RW_HEAD_DIM), jnp.float32)
    yr_c = yr_l = 0.0
    for d in range(2):
        rev = d == 1
        s_c, y_c = _rwkv7_scan(s0, fc['r'], fc['w'][d], fc['k'][d], fc['v'], fc['kk'], fc['a'][d], rev, emit_ctx)
        _, y_l = _rwkv7_scan(s_c, fl['r'], fl['w'][d], fl['k'][d], fl['v'], fl['kk'], fl['a'][d], rev, True)
        yr_l = yr_l + y_l
        if emit_ctx:
            yr_c = yr_c + y_c

    gc = _gla_inputs(pg_c, gla_a2, gla_ab)
    gl = _gla_inputs(pg_l, gla_a2, gla_ab)
    col = lambda t: _grid_transpose(t, rows, GRID_W)
    q_l, k_l, v_l = col(gl['q']), col(gl['k']), col(gl['v'])
    s0g = jnp.zeros((B, GLA_HEADS, GLA_KEY_DIM, GLA_VAL_DIM), jnp.float32)
    og_c = og_l = 0.0
    for d in range(2):
        rev = d == 1
        s_c, o_c = _gla_scan(s0g, gc['q'], gc['k'], gc['v'], gc['log_a'][d], rev, emit_ctx)
        _, o_l = _gla_scan(s_c, q_l, k_l, v_l, col(gl['log_a'][d]), rev, True)
        og_l = og_l + o_l
        if emit_ctx:
            og_c = og_c + o_c
    og_l = _grid_transpose(og_l, GRID_W, rows)

    m_lat = jnp.concatenate([_rwkv_output(yr_l, fl, r_k, ln_w, ln_b, g2),
                             _gla_output(og_l, gl['og'], gla_g)], axis=-1)
    m_ctx = None
    if emit_ctx:
        m_ctx = jnp.concatenate([_rwkv_output(yr_c, fc, r_k, ln_w, ln_b, g2),
                                 _gla_output(og_c, gc['og'], gla_g)], axis=-1)
    return m_ctx, m_lat


def setup_inputs(seed: int = 0) -> dict:
    key = jax.random.key(seed)
    ks = jax.random.split(key, 32)
    nrm = lambda k, shape, scale: jax.random.normal(k, shape, jnp.float32) * scale
    L, D = DEPTH, D_MODEL
    return {
        "x": nrm(ks[0], (BATCH, SEQ, D), 1.0),
        "c": nrm(ks[1], (BATCH, D), 1.0),
        "ctx": nrm(ks[2], (BATCH, CTX_LEN, D), 1.0),
        "c_ctx": nrm(ks[3], (D,), 1.0),
        "w_mod": nrm(ks[4], (L, D, 6 * D), 0.5 * D ** -0.5),
        "b_mod": nrm(ks[5], (L, 6 * D), 0.02),
        "norm1_g": 1.0 + nrm(ks[6], (L, D), 0.02),
        "w_in": nrm(ks[7], (L, D, N_IN), D ** -0.5),
        "rwkv_mu": jax.random.uniform(ks[8], (L, RW_COLS), jnp.float32),
        "rwkv_w0": jax.random.uniform(ks[9], (L, 2, RW_WIDTH), jnp.float32, -5.0, 0.0),
        "rwkv_w2": nrm(ks[10], (L, 2, RW_DECAY_RANK, RW_WIDTH), 0.5 * RW_DECAY_RANK ** -0.5),
        "rwkv_a0": nrm(ks[11], (L, 2, RW_WIDTH), 0.5),
        "rwkv_a2": nrm(ks[12], (L, 2, RW_ICLR_RANK, RW_WIDTH), 0.5 * RW_ICLR_RANK ** -0.5),
        "rwkv_g2": nrm(ks[13], (L, RW_GATE_RANK, RW_WIDTH), RW_GATE_RANK ** -0.5),
        "rwkv_k_k": 0.85 + nrm(ks[14], (L, RW_WIDTH), 0.02),
        "rwkv_k_a": 1.0 + nrm(ks[15], (L, RW_WIDTH), 0.02),
        "rwkv_r_k": nrm(ks[16], (L, RW_HEADS, RW_HEAD_DIM), 0.1),
        "rwkv_ln_w": 1.0 + nrm(ks[17], (L, RW_WIDTH), 0.02),
        "rwkv_ln_b": nrm(ks[18], (L, RW_WIDTH), 0.02),
        "gla_a2": nrm(ks[19], (L, 2, GLA_GATE_RANK, GLA_QK_WIDTH), GLA_GATE_RANK ** -0.5),
        "gla_ab": jax.random.uniform(ks[20], (L, 2, GLA_QK_WIDTH), jnp.float32, 0.0, 3.0),
        "gla_norm_g": 1.0 + nrm(ks[21], (L, GLA_VAL_DIM), 0.02),
        "w_out": nrm(ks[22], (L, MIX_WIDTH, D), MIX_WIDTH ** -0.5),
        "norm2_g": 1.0 + nrm(ks[23], (L, D), 0.02),
        "w_ffn_in": nrm(ks[24], (L, D, 2 * FFN_HIDDEN), D ** -0.5),
        "w_ffn_out": nrm(ks[25], (L, FFN_HIDDEN, D), FFN_HIDDEN ** -0.5),
        "norm_f_g": 1.0 + nrm(ks[26], (D,), 0.02),
    }


def reference(x, c, ctx, c_ctx, w_mod, b_mod, norm1_g, w_in, rwkv_mu, rwkv_w0, rwkv_w2, rwkv_a0, rwkv_a2,
              rwkv_g2, rwkv_k_k, rwkv_k_a, rwkv_r_k, rwkv_ln_w, rwkv_ln_b, gla_a2, gla_ab, gla_norm_g,
              w_out, norm2_g, w_ffn_in, w_ffn_out, norm_f_g):
    B, T, _ = x.shape
    rows = T // GRID_W
    silu_c = jax.nn.silu(c)
    silu_cc = jax.nn.silu(c_ctx)
    h, hc = x, ctx
    for l in range(DEPTH):
        emit_ctx = l < DEPTH - 1
        sh1, sc1, gt1, sh2, sc2, gt2 = jnp.split((silu_c @ w_mod[l] + b_mod[l])[:, None, :], 6, axis=-1)
        ch1, cc1, cg1, ch2, cc2, cg2 = jnp.split(silu_cc @ w_mod[l] + b_mod[l], 6, axis=-1)
        p_lat = _modulate(_rmsnorm(h, norm1_g[l]), sh1, sc1) @ w_in[l]
        p_ctx = _modulate(_rmsnorm(hc, norm1_g[l]), ch1, cc1) @ w_in[l]
        m_ctx, m_lat = _token_mixers(p_ctx, p_lat, rows, emit_ctx, rwkv_mu[l], rwkv_w0[l], rwkv_w2[l],
                                     rwkv_a0[l], rwkv_a2[l], rwkv_g2[l], rwkv_k_k[l], rwkv_k_a[l],
                                     rwkv_r_k[l], rwkv_ln_w[l], rwkv_ln_b[l], gla_a2[l], gla_ab[l],
                                     gla_norm_g[l])
        h = h + gt1 * (m_lat @ w_out[l])
        h = h + gt2 * _swiglu(_modulate(_rmsnorm(h, norm2_g[l]), sh2, sc2), w_ffn_in[l], w_ffn_out[l])
        if emit_ctx:
            hc = hc + cg1 * (m_ctx @ w_out[l])
            hc = hc + cg2 * _swiglu(_modulate(_rmsnorm(hc, norm2_g[l]), ch2, cc2), w_ffn_in[l], w_ffn_out[l])
    return _rmsnorm(h, norm_f_g).astype(x.dtype)
```

```cpp
#include <hip/hip_runtime.h>
#include <hip/hip_cooperative_groups.h>
#include <cstdio>
#include <cstdint>
namespace cg = cooperative_groups;
namespace pg8 {
#define PG8_LAS __attribute__((address_space(3)))
typedef unsigned short bf16_t;
typedef short bf16x8 __attribute__((ext_vector_type(8)));
typedef float f32x4 __attribute__((ext_vector_type(4)));
typedef unsigned u32x4 __attribute__((ext_vector_type(4)));
constexpr int BM = 256, BK = 64, HALF = 128, HTB = HALF * BK * 2  , STAGE_BYTES = 8 * HTB, NXCD = 8, WGM = 8;

__host__ __device__ __forceinline__ int lds_byte(int r, int c) { const int st = (r >> 4) * 2 + (c >> 5), rr = r & 15, cc = c & 31, ob = rr * 64 + cc * 2; return st * 1024 + (ob ^ (((ob >> 9) & 1) << 5)); }
__host__ __device__ __forceinline__ void stage_rc(int b, int& R, int& C) { const int st = b / 1024, sb = b % 1024, swz = sb ^ (((sb >> 9) & 1) << 5); R = (st >> 1) * 16 + swz / 64; C = (st & 1) * 32 + (swz % 64) / 2; }
__host__ __device__ __forceinline__ int perm32(int rho) { const int n = rho >> 4, i = rho & 15; return 8 * (i >> 2) + 4 * n + (i & 3); }

struct Unit { int pm, pn; };
struct Gemm { const bf16_t* A; const bf16_t* Bt; int M, N, K; int lda, acol4, acol8; };

struct StaticOrder {
    int nM, nN, nwg, G, c;
    __host__ __device__ void init(int M, int N, int G_, int c_) { nM = M / BM; nN = N / BM; nwg = nM * nN; G = G_; c = c_; }
    __host__ __device__ bool next(int i, Unit& u) const {
        const long L = (long)i * G + c; if (L >= nwg) return false;
        int wgid = (int)L; { const int q = nwg / NXCD, r = nwg % NXCD, xcd = wgid % NXCD, off = wgid / NXCD; wgid = (xcd < r ? xcd * (q + 1) : r * (q + 1) + (xcd - r) * q) + off; }
        const int nig = WGM * nN, gid = wgid / nig, fm = gid * WGM, gsz = (nM - fm) < WGM ? (nM - fm) : WGM;
        u.pm = fm + ((wgid % nig) % gsz); u.pn = (wgid % nig) / gsz; return true;
    }
    __device__ __forceinline__ void a_ready(const Unit&) const {}
    __device__ __forceinline__ void done(const Unit&) const {}
};

typedef __bf16 bf16v2_t __attribute__((ext_vector_type(2)));
typedef float f32v2_t __attribute__((ext_vector_type(2)));
__device__ __forceinline__ unsigned cvt_pk_bf16(float lo, float hi) { const f32v2_t v = {lo, hi}; const bf16v2_t b = __builtin_convertvector(v, bf16v2_t); return __builtin_bit_cast(unsigned, b); }
typedef float f32x2 __attribute__((ext_vector_type(2)));
__device__ __forceinline__ f32x2 gelu_pk(f32x2 v) {
    const f32x2 av = __builtin_elementwise_abs(v), d = av * 0.2316418882f + 1.0f;
    f32x2 t; t.x = __builtin_amdgcn_rcpf(d.x); t.y = __builtin_amdgcn_rcpf(d.y);
    f32x2 q = t * 0.5307027145f + (-0.7265760135f); q = q * t + 0.7107068705f; q = q * t + (-0.142248368f); q = q * t + 0.127414796f; q = q * t;
    const f32x2 s = (v * v) * (-0.72134752044f);
    f32x2 e; e.x = __builtin_amdgcn_exp2f(s.x); e.y = __builtin_amdgcn_exp2f(s.y);
    const f32x2 m = v * (q * e), r = v - m;
    f32x2 o; o.x = v.x < 0.f ? m.x : r.x; o.y = v.y < 0.f ? m.y : r.y; return o;
}

template <int ACT  > struct EpiBf16 {
    static constexpr bool PERM = true, AFTER_DRAIN = false; static_assert(ACT == 0 || ACT == 1, "EpiBf16: ACT is 0 (none) or 1 (gelu_pk)");
    bf16_t* O; int ldc; const float* bias; int split_cols; size_t split_stride; float scale0;
    __device__ __forceinline__ void operator()(const f32x4 (&acc)[2][2][4][2], const Unit& u, int wr, int wc, int fr, int fq) const {
        const int row0 = u.pm * BM + wr * 64 + fr; int colt = u.pn * BM; bf16_t* base = O;
        float sc = 1.f; if (split_cols) { const int t = colt / split_cols; base += (size_t)t * split_stride; colt -= t * split_cols; if (t == 0) sc = scale0; }
        const int col0 = colt + wc * 32 + 8 * fq, bcol0 = u.pn * BM + wc * 32 + 8 * fq;
        f32x4 bv[2][2];
#pragma unroll
        for (int bj = 0; bj < 2; ++bj)
#pragma unroll
            for (int n = 0; n < 2; ++n) bv[bj][n] = bias ? *(const f32x4*)(bias + bcol0 + bj * HALF + 4 * n) : (f32x4){0.f, 0.f, 0.f, 0.f};
#pragma unroll
        for (int ai = 0; ai < 2; ++ai)
#pragma unroll
            for (int m = 0; m < 4; ++m) { bf16_t* rowp = base + (size_t)(row0 + ai * HALF + m * 16) * ldc + col0;
#pragma unroll
                for (int bj = 0; bj < 2; ++bj) { f32x4 v0 = acc[ai][bj][m][0] + bv[bj][0], v1 = acc[ai][bj][m][1] + bv[bj][1];
                    if (ACT == 1) { f32x2 a = gelu_pk((f32x2){v0[0], v0[1]}), b = gelu_pk((f32x2){v0[2], v0[3]}), c = gelu_pk((f32x2){v1[0], v1[1]}), d = gelu_pk((f32x2){v1[2], v1[3]});
                        v0 = (f32x4){a.x, a.y, b.x, b.y}; v1 = (f32x4){c.x, c.y, d.x, d.y}; }
                    v0 = v0 * sc; v1 = v1 * sc; u32x4 w; w.x = cvt_pk_bf16(v0[0], v0[1]); w.y = cvt_pk_bf16(v0[2], v0[3]); w.z = cvt_pk_bf16(v1[0], v1[1]); w.w = cvt_pk_bf16(v1[2], v1[3]);
                    *(u32x4*)(rowp + bj * HALF) = w; } }
    }
};
__device__ __forceinline__ float sigmoidf_(float v) { return __builtin_amdgcn_rcpf(1.0f + __expf(-v)); }
struct EpiLora {
    static constexpr bool PERM = true, AFTER_DRAIN = false;
    bf16_t* O; int ldc; const float* w0; const float* a0;
    __device__ __forceinline__ void operator()(const f32x4 (&acc)[2][2][4][2], const Unit& u, int wr, int wc, int fr, int fq) const {
        const int row0 = u.pm * BM + wr * 64 + fr; const int col0 = u.pn * BM + wc * 32 + 8 * fq;
        if (u.pn < 8) {
            const float sc = u.pn < 4 ? 0.60653065971f : 1.0f;
            const float* bp = u.pn < 4 ? (w0 + col0) : (a0 + (col0 - 1024));
#pragma unroll
            for (int bj = 0; bj < 2; ++bj) { const f32x4 b0 = *(const f32x4*)(bp + bj * HALF), b1 = *(const f32x4*)(bp + bj * HALF + 4);
#pragma unroll
                for (int ai = 0; ai < 2; ++ai)
#pragma unroll
                    for (int m = 0; m < 4; ++m) { f32x4 v0 = acc[ai][bj][m][0] + b0, v1 = acc[ai][bj][m][1] + b1;
#pragma unroll
                        for (int e = 0; e < 4; ++e) { v0[e] = sigmoidf_(v0[e]) * sc; v1[e] = sigmoidf_(v1[e]) * sc; }
                        u32x4 w; w.x = cvt_pk_bf16(v0[0], v0[1]); w.y = cvt_pk_bf16(v0[2], v0[3]); w.z = cvt_pk_bf16(v1[0], v1[1]); w.w = cvt_pk_bf16(v1[2], v1[3]);
                        *(u32x4*)(O + (size_t)(row0 + ai * HALF + m * 16) * ldc + col0 + bj * HALF) = w; } }
        } else {
#pragma unroll
            for (int bj = 0; bj < 2; ++bj)
#pragma unroll
                for (int ai = 0; ai < 2; ++ai)
#pragma unroll
                    for (int m = 0; m < 4; ++m) { const f32x4 v0 = acc[ai][bj][m][0], v1 = acc[ai][bj][m][1];
                        u32x4 w; w.x = cvt_pk_bf16(v0[0], v0[1]); w.y = cvt_pk_bf16(v0[2], v0[3]); w.z = cvt_pk_bf16(v1[0], v1[1]); w.w = cvt_pk_bf16(v1[2], v1[3]);
                        *(u32x4*)(O + (size_t)(row0 + ai * HALF + m * 16) * ldc + col0 + bj * HALF) = w; }
        }
    }
};
template <bool BF16_BASE, bool BF16_OUT> struct EpiGateRes {
    static constexpr bool PERM = true, AFTER_DRAIN = false;
    const void* base; const float* gate; void* out; int ldc; int gstride;
    __device__ __forceinline__ void operator()(const f32x4 (&acc)[2][2][4][2], const Unit& u, int wr, int wc, int fr, int fq) const {
        const int col0 = u.pn * BM + wc * 32 + 8 * fq;
        const float* gp = gate + (size_t)((u.pm * BM) >> 12) * gstride + col0;
        f32x4 gv[2][2];
#pragma unroll
        for (int bj = 0; bj < 2; ++bj)
#pragma unroll
            for (int n = 0; n < 2; ++n) gv[bj][n] = *(const f32x4*)(gp + bj * HALF + 4 * n);
#pragma unroll
        for (int ai = 0; ai < 2; ++ai)
#pragma unroll
            for (int m = 0; m < 4; ++m) { const size_t off = (size_t)(u.pm * BM + ai * HALF + wr * 64 + m * 16 + fr) * ldc + col0;
#pragma unroll
                for (int bj = 0; bj < 2; ++bj) { f32x4 b0, b1;
                    if (BF16_BASE) { const u32x4 w = *(const u32x4*)((const bf16_t*)base + off + bj * HALF);
                        b0 = (f32x4){__uint_as_float(w.x << 16), __uint_as_float(w.x & 0xffff0000u), __uint_as_float(w.y << 16), __uint_as_float(w.y & 0xffff0000u)};
                        b1 = (f32x4){__uint_as_float(w.z << 16), __uint_as_float(w.z & 0xffff0000u), __uint_as_float(w.w << 16), __uint_as_float(w.w & 0xffff0000u)}; }
                    else { b0 = *(const f32x4*)((const float*)base + off + bj * HALF); b1 = *(const f32x4*)((const float*)base + off + bj * HALF + 4); }
                    const f32x4 o0 = b0 + gv[bj][0] * acc[ai][bj][m][0], o1 = b1 + gv[bj][1] * acc[ai][bj][m][1];
                    if (BF16_OUT) { u32x4 w; w.x = cvt_pk_bf16(o0[0], o0[1]); w.y = cvt_pk_bf16(o0[2], o0[3]); w.z = cvt_pk_bf16(o1[0], o1[1]); w.w = cvt_pk_bf16(o1[2], o1[3]);
                        *(u32x4*)((bf16_t*)out + off + bj * HALF) = w; }
                    else { *(f32x4*)((float*)out + off + bj * HALF) = o0; *(f32x4*)((float*)out + off + bj * HALF + 4) = o1; } } }
    }
};
struct EpiSwiglu {
    static constexpr bool PERM = true, AFTER_DRAIN = false;
    bf16_t* O; int ldo;
    __device__ __forceinline__ void operator()(const f32x4 (&acc)[2][2][4][2], const Unit& u, int wr, int wc, int fr, int fq) const {
        const int row0 = u.pm * BM + wr * 64 + fr; const int h0 = (u.pn * BM + wc * 32 + 8 * fq) >> 1;
        typedef unsigned u32x2v __attribute__((ext_vector_type(2)));
#pragma unroll
        for (int ai = 0; ai < 2; ++ai)
#pragma unroll
            for (int m = 0; m < 4; ++m) { bf16_t* rowp = O + (size_t)(row0 + ai * HALF + m * 16) * ldo + h0;
#pragma unroll
                for (int bj = 0; bj < 2; ++bj) { const f32x4 g = acc[ai][bj][m][0], up = acc[ai][bj][m][1]; f32x4 h;
#pragma unroll
                    for (int e = 0; e < 4; ++e) h[e] = g[e] * sigmoidf_(g[e]) * up[e];
                    u32x2v w; w.x = cvt_pk_bf16(h[0], h[1]); w.y = cvt_pk_bf16(h[2], h[3]);
                    *(u32x2v*)(rowp + bj * (HALF / 2)) = w; } }
    }
};
template <class Epi, class Sched, bool ALIGN_EPI = false, bool SP2 = false>
__device__ __forceinline__ void gemm_phase(PG8_LAS unsigned char* lds, const Gemm g, const Sched& S, const Epi& E) {
    const int tid = threadIdx.x, wid = __builtin_amdgcn_readfirstlane(tid >> 6), lane = tid & 63, wr = wid >> 2, wc = wid & 3, fr = lane & 15, fq = lane >> 4;
    const int K = g.K, nt = K / BK;
    const int lda = g.lda ? g.lda : K;
    unsigned voffA[2], voffB[2];
#pragma unroll
    for (int i = 0; i < 2; ++i) { int R, C; stage_rc(tid * 16 + i * 8192, R, C); const int Rb = Epi::PERM ? ((R & ~31) + perm32(R & 31)) : R;
        voffA[i] = (unsigned)(R * lda + C) * 2u; voffB[i] = (unsigned)(Rb * K + C) * 2u; }
    const size_t kstep = (size_t)(BK * 2);
    const size_t hstep = (size_t)HALF * K * 2;
    const size_t tstep = 2 * hstep;
    const size_t hstepA = (size_t)HALF * lda * 2, tstepA = 2 * hstepA;
#define PG8_ACOL(pn) ((size_t)((pn) < 4 ? 0 : ((pn) < 8 ? g.acol4 : g.acol8)) * 2)
    const unsigned ldsw = (unsigned)wid * 1024u;
    const int aoff = lds_byte(wr * 64 + fr, fq * 8), boff = lds_byte(wc * 32 + fr, fq * 8);
#define PG8_SA(b, h) (((b) * 2 + (h)) * HTB)
#define PG8_SB(b, h) ((4 + (b) * 2 + (h)) * HTB)
#define PG8_STAGE(bufoff, gbase, voff) do { _Pragma("unroll") for (int _i = 0; _i < 2; ++_i) \
        __builtin_amdgcn_global_load_lds((const unsigned*)((const char*)(gbase) + (voff)[_i]), (PG8_LAS unsigned*)(lds + (bufoff) + ldsw + _i * 8192), 16, 0, 0); } while (0)
#define PG8_LDA(dst, b, h) do { _Pragma("unroll") for (int m = 0; m < 4; ++m) _Pragma("unroll") for (int k = 0; k < 2; ++k) dst[m][k] = *(const PG8_LAS bf16x8*)(lds + PG8_SA(b, h) + aoff + m * 2048 + k * 1024); } while (0)
#define PG8_LDB(dst, b, h) do { _Pragma("unroll") for (int n = 0; n < 2; ++n) _Pragma("unroll") for (int k = 0; k < 2; ++k) dst[n][k] = *(const PG8_LAS bf16x8*)(lds + PG8_SB(b, h) + boff + n * 2048 + k * 1024); } while (0)
#define PG8_MMA(ai, bj, At, Bt) do { __builtin_amdgcn_s_setprio(1); _Pragma("unroll") for (int m = 0; m < 4; ++m) _Pragma("unroll") for (int n = 0; n < 2; ++n) _Pragma("unroll") for (int k = 0; k < 2; ++k) \
        acc[ai][bj][m][n] = __builtin_amdgcn_mfma_f32_16x16x32_bf16(Bt[n][k], At[m][k], acc[ai][bj][m][n], 0, 0, 0); __builtin_amdgcn_s_setprio(0); } while (0)
#define PG8_WAIT_V(n) asm volatile("s_waitcnt vmcnt(" #n ")" ::: "memory")
#define PG8_WAIT_L(n) asm volatile("s_waitcnt lgkmcnt(" #n ")" ::: "memory")
#define PG8_BAR __builtin_amdgcn_s_barrier()
#define PG8_SCHED __builtin_amdgcn_sched_barrier(0)
    Unit cur, nxt; int ui = 0;
    if (!S.next(0, cur)) return;
    f32x4 acc[2][2][4][2];
#pragma unroll
    for (int a = 0; a < 2; ++a)
#pragma unroll
        for (int b = 0; b < 2; ++b)
#pragma unroll
            for (int m = 0; m < 4; ++m)
#pragma unroll
                for (int n = 0; n < 2; ++n) acc[a][b][m][n] = (f32x4){0.f, 0.f, 0.f, 0.f};
    bf16x8 At[4][2], B0[2][2], B1[2][2];
    const char* cA = (const char*)g.A + (size_t)cur.pm * tstepA + PG8_ACOL(cur.pn); const char* cB = (const char*)g.Bt + (size_t)cur.pn * tstep;
    S.a_ready(cur);
    if constexpr (SP2) {
        PG8_STAGE(PG8_SB(0, 0), cB, voffB); PG8_STAGE(PG8_SB(0, 1), cB + hstep, voffB); PG8_STAGE(PG8_SA(0, 0), cA, voffA); PG8_STAGE(PG8_SA(0, 1), cA + hstepA, voffA);
        if (wr == 1) PG8_BAR;
        PG8_WAIT_V(2); PG8_BAR;
        PG8_STAGE(PG8_SB(1, 0), cB + kstep, voffB); PG8_STAGE(PG8_SA(1, 0), cA + kstep, voffA); PG8_STAGE(PG8_SB(1, 1), cB + hstep + kstep, voffB);
        PG8_WAIT_V(6); PG8_BAR;
    } else {
        PG8_STAGE(PG8_SB(0, 0), cB, voffB); PG8_STAGE(PG8_SA(0, 0), cA, voffA); PG8_STAGE(PG8_SB(0, 1), cB + hstep, voffB); PG8_STAGE(PG8_SA(0, 1), cA + hstepA, voffA);
        if (wr == 1) PG8_BAR;
        PG8_WAIT_V(4); PG8_BAR;
        PG8_STAGE(PG8_SB(1, 0), cB + kstep, voffB); PG8_STAGE(PG8_SA(1, 0), cA + kstep, voffA); PG8_STAGE(PG8_SB(1, 1), cB + hstep + kstep, voffB);
        PG8_WAIT_V(6); PG8_BAR;
    }
    for (;;) {
        const bool has_next = S.next(ui + 1, nxt);
        const char* nA = has_next ? (const char*)g.A + (size_t)nxt.pm * tstepA + PG8_ACOL(nxt.pn) : cA; const char* nB = has_next ? (const char*)g.Bt + (size_t)nxt.pn * tstep : cB;
        for (int t = 0; t < nt; t += 2) {
            const bool last = (t == nt - 2);
            const char* a1 = cA + (size_t)(t + 1) * kstep;
            const char* a2 = last ? nA : cA + (size_t)(t + 2) * kstep; const char* b2 = last ? nB : cB + (size_t)(t + 2) * kstep;
            const char* a3 = a2 + kstep; const char* b3 = b2 + kstep;
            if (last && has_next) S.a_ready(nxt);
            if constexpr (SP2) {
            PG8_LDB(B0, 0, 0); PG8_LDB(B1, 0, 1); PG8_SCHED; PG8_LDA(At, 0, 0); PG8_STAGE(PG8_SA(1, 1), a1 + hstepA, voffA);
            PG8_WAIT_V(8); PG8_WAIT_L(0); PG8_BAR; PG8_MMA(0, 0, At, B0); PG8_MMA(0, 1, At, B1); PG8_BAR; PG8_SCHED;
            PG8_LDA(At, 0, 1); PG8_STAGE(PG8_SB(0, 0), b2, voffB); PG8_STAGE(PG8_SB(0, 1), b2 + hstep, voffB); PG8_STAGE(PG8_SA(0, 0), a2, voffA);
            PG8_WAIT_V(8); PG8_WAIT_L(0); PG8_BAR; PG8_MMA(1, 0, At, B0); PG8_MMA(1, 1, At, B1); PG8_BAR; PG8_SCHED;
            PG8_LDB(B0, 1, 0); PG8_LDB(B1, 1, 1); PG8_SCHED; PG8_LDA(At, 1, 0); PG8_STAGE(PG8_SA(0, 1), a2 + hstepA, voffA);
            PG8_WAIT_V(8); PG8_WAIT_L(0); PG8_BAR; PG8_MMA(0, 0, At, B0); PG8_MMA(0, 1, At, B1); PG8_BAR; PG8_SCHED;
            PG8_LDA(At, 1, 1); PG8_STAGE(PG8_SB(1, 0), b3, voffB); PG8_STAGE(PG8_SB(1, 1), b3 + hstep, voffB); PG8_STAGE(PG8_SA(1, 0), a3, voffA);
            PG8_WAIT_V(8); PG8_WAIT_L(0); PG8_BAR; PG8_MMA(1, 0, At, B0); PG8_MMA(1, 1, At, B1); PG8_BAR; PG8_SCHED;
            } else {
            PG8_LDB(B0, 0, 0); PG8_SCHED; PG8_LDA(At, 0, 0); PG8_STAGE(PG8_SA(1, 1), a1 + hstepA, voffA);
            PG8_WAIT_L(8); PG8_BAR; PG8_WAIT_L(0); PG8_MMA(0, 0, At, B0); PG8_BAR; PG8_SCHED;
            PG8_LDB(B1, 0, 1); PG8_STAGE(PG8_SB(0, 0), b2, voffB);
            PG8_BAR; PG8_WAIT_L(0); PG8_MMA(0, 1, At, B1); PG8_BAR;
            PG8_LDA(At, 0, 1); PG8_STAGE(PG8_SA(0, 0), a2, voffA);
            PG8_BAR; PG8_WAIT_L(0); PG8_MMA(1, 0, At, B0); PG8_BAR; PG8_SCHED;
            PG8_STAGE(PG8_SB(0, 1), b2 + hstep, voffB);
            PG8_WAIT_V(6); PG8_BAR; PG8_MMA(1, 1, At, B1); PG8_BAR;
            PG8_LDB(B0, 1, 0); PG8_SCHED; PG8_LDA(At, 1, 0); PG8_STAGE(PG8_SA(0, 1), a2 + hstepA, voffA);
            PG8_WAIT_L(8); PG8_BAR; PG8_WAIT_L(0); PG8_MMA(0, 0, At, B0); PG8_BAR; PG8_SCHED;
            PG8_LDB(B1, 1, 1); PG8_STAGE(PG8_SB(1, 0), b3, voffB);
            PG8_BAR; PG8_WAIT_L(0); PG8_MMA(0, 1, At, B1); PG8_BAR;
            PG8_LDA(At, 1, 1); PG8_STAGE(PG8_SA(1, 0), a3, voffA);
            PG8_BAR; PG8_WAIT_L(0); PG8_MMA(1, 0, At, B0); PG8_BAR; PG8_SCHED;
            PG8_STAGE(PG8_SB(1, 1), b3 + hstep, voffB);
            PG8_WAIT_V(6); PG8_BAR; PG8_MMA(1, 1, At, B1); PG8_BAR;
            }
        }
        if constexpr (ALIGN_EPI) { if (wr == 0) PG8_BAR; }
        if constexpr (!Epi::AFTER_DRAIN) { E(acc, cur, wr, wc, fr, fq); S.done(cur); }
        if (!has_next) break;
#pragma unroll
        for (int a = 0; a < 2; ++a)
#pragma unroll
            for (int b = 0; b < 2; ++b)
#pragma unroll
                for (int m = 0; m < 4; ++m)
#pragma unroll
                    for (int n = 0; n < 2; ++n) acc[a][b][m][n] = (f32x4){0.f, 0.f, 0.f, 0.f};
        cur = nxt; cA = nA; cB = nB; ++ui;
        if constexpr (ALIGN_EPI) { if (wr == 1) PG8_BAR; }
    }
    PG8_WAIT_V(0);
    if constexpr (!ALIGN_EPI) { if (wr == 0) PG8_BAR; }
    PG8_BAR;
    if constexpr (Epi::AFTER_DRAIN) { E.fused(acc, cur, wr, wc, fr, fq, lds, wid, lane); S.done(cur); }
#undef PG8_ACOL
#undef PG8_SA
#undef PG8_SB
#undef PG8_STAGE
#undef PG8_LDA
#undef PG8_LDB
#undef PG8_MMA
#undef PG8_WAIT_V
#undef PG8_WAIT_L
#undef PG8_BAR
#undef PG8_SCHED
}
}
#define LAS __attribute__((address_space(3)))
typedef unsigned short bf16;
typedef unsigned u32x4 __attribute__((ext_vector_type(4)));
typedef unsigned u32x2 __attribute__((ext_vector_type(2)));
typedef float f32x4 __attribute__((ext_vector_type(4)));
typedef short bf16x8 __attribute__((ext_vector_type(8)));
constexpr int NB = 8, TL = 4096, DM = 1024, CTXL = 256;
constexpr int ML = NB * TL, MC = NB * CTXL, MT = ML + MC;
constexpr int NIN = 3488, NINP = 3584, FF = 2816, NLO = 2560, KLO = 384, KLB = 128, MODN = 6144;
constexpr int PC_K = 512, PC_V = 1024, PC_LORA = 1536, PC_GQ = 1920, PC_GK = 2176, PC_GV = 2432, PC_GLF = 2944, PC_GOG = 2976;
constexpr int NSLOT = 68;
constexpr size_t MiB = 1u << 20;
constexpr size_t WS_WIN = 1 * MiB, WS_WOUT = 8 * MiB, WS_WFFI = 10 * MiB, WS_WFFO = 21 * MiB, WS_WLORA = 27 * MiB, WS_MOD = 29 * MiB, WS_GAM = 30 * MiB;
constexpr size_t WS_P = 32 * MiB, WS_XN = 270 * MiB, WS_WAG = 270 * MiB, WS_GS = 440 * MiB, WS_END = 508 * MiB;
constexpr size_t WS_H = 32 * MiB, WS_H2 = 96 * MiB, WS_XN2 = 160 * MiB, WS_HMID = 270 * MiB;
static_assert(WS_P + (size_t)MT * NINP * 2 <= WS_XN && WS_WAG + (size_t)MT * NLO * 2 <= WS_GS && WS_GS + (size_t)NB * 4 * 2 * NSLOT * 16384 <= WS_END, "ws map");
static_assert(WS_XN2 + (size_t)ML * DM * 2 <= WS_HMID && WS_HMID + (size_t)ML * FF * 2 <= WS_END && WS_GAM + (size_t)NB * 4 * 2 * NSLOT * 64 * 4 <= WS_P, "ws map 2");
constexpr int LDS_BYTES = 147456;

struct Args { const float* in[27]; float* out; unsigned char* ws; };

#define LDS_WAIT() asm volatile("s_waitcnt lgkmcnt(0)" ::: "memory")
__device__ __forceinline__ unsigned pk2(float lo, float hi) { return pg8::cvt_pk_bf16(lo, hi); }
__device__ __forceinline__ float bflo(unsigned u) { return __uint_as_float(u << 16); }
__device__ __forceinline__ float bfhi(unsigned u) { return __uint_as_float(u & 0xffff0000u); }
__device__ __forceinline__ float bf1(bf16 u) { return __uint_as_float((unsigned)u << 16); }
__device__ __forceinline__ float wave_sum(float v) {
#pragma unroll
    for (int o = 1; o < 64; o <<= 1) v += __shfl_xor(v, o);
    return v;
}
template <int CTRL> __device__ __forceinline__ float dppf(float x) { return __builtin_bit_cast(float, __builtin_amdgcn_update_dpp(0, __builtin_bit_cast(int, x), CTRL, 0xF, 0xF, true)); }
__device__ __forceinline__ float red8(float x) { x += dppf<0xB1>(x); x += dppf<0x4E>(x); x += dppf<0x141>(x); return x; }
__device__ __forceinline__ float red16(float x) { x = red8(x); x += dppf<0x140>(x); return x; }
__device__ __forceinline__ float sigm(float v) { return __builtin_amdgcn_rcpf(1.0f + __expf(-v)); }
__device__ __forceinline__ float logsigm(float x) { return fminf(x, 0.f) - __logf(1.0f + __expf(-fabsf(x))); }

struct Nb4 { int n0, n1, n2, n3; };
__device__ __forceinline__ Nb4 neighbors(int R) {
    Nb4 n;
    if (R < ML) { const int t = R & (TL - 1), gc = t & 63, gr = t >> 6; n.n0 = gc > 0 ? R - 1 : -1; n.n1 = gc < 63 ? R + 1 : -1; n.n2 = gr > 0 ? R - 64 : -1; n.n3 = gr < 63 ? R + 64 : -1; }
    else { const int t = (R - ML) & (CTXL - 1); const int pv = t > 0 ? R - 1 : -1, nx = t < CTXL - 1 ? R + 1 : -1; n.n0 = pv; n.n1 = nx; n.n2 = pv; n.n3 = nx; }
    return n;
}
struct Raw5 { u32x4 o, a, b, c, d; };
__device__ __forceinline__ u32x4 ldrow(const bf16* P, int R, int col) { return R >= 0 ? *(const u32x4*)(P + (size_t)R * NINP + col) : (u32x4){0u, 0u, 0u, 0u}; }
__device__ __forceinline__ Raw5 load_raw5(const bf16* P, int R, const Nb4& nb, int col) {
    Raw5 r; r.o = ldrow(P, R, col); r.a = ldrow(P, nb.n0, col); r.b = ldrow(P, nb.n1, col); r.c = ldrow(P, nb.n2, col); r.d = ldrow(P, nb.n3, col); return r;
}
__device__ __forceinline__ float lerpf_(float p, float s, float m) { return p + (s - p) * m; }
__device__ __forceinline__ void xm8(const Raw5& r, const float* mu, float (&o)[8]) {
    const f32x4 m0 = *(const f32x4*)mu, m1 = *(const f32x4*)(mu + 4);
    o[0] = lerpf_(bflo(r.o.x), bflo(r.a.x), m0[0]); o[1] = lerpf_(bfhi(r.o.x), bfhi(r.b.x), m0[1]);
    o[2] = lerpf_(bflo(r.o.y), bflo(r.c.y), m0[2]); o[3] = lerpf_(bfhi(r.o.y), bfhi(r.d.y), m0[3]);
    o[4] = lerpf_(bflo(r.o.z), bflo(r.a.z), m1[0]); o[5] = lerpf_(bfhi(r.o.z), bfhi(r.b.z), m1[1]);
    o[6] = lerpf_(bflo(r.o.w), bflo(r.c.w), m1[2]); o[7] = lerpf_(bfhi(r.o.w), bfhi(r.d.w), m1[3]);
}
__device__ __forceinline__ void unpack8(const u32x4& v, float (&o)[8]) {
    o[0] = bflo(v.x); o[1] = bfhi(v.x); o[2] = bflo(v.y); o[3] = bfhi(v.y); o[4] = bflo(v.z); o[5] = bfhi(v.z); o[6] = bflo(v.w); o[7] = bfhi(v.w);
}
__device__ __forceinline__ u32x4 pack8(const float (&o)[8]) { u32x4 w; w.x = pk2(o[0], o[1]); w.y = pk2(o[2], o[3]); w.z = pk2(o[4], o[5]); w.w = pk2(o[6], o[7]); return w; }

__device__ __forceinline__ void transpose_item(const float* W, int N, bf16* WT, int ldk, int koff, int row_base, bool perm, LAS float* scr, int item, int lane) {
    const int nblk = N / 32, kb = item / nblk, nbk = item % nblk, k0 = 64 * kb, n0 = 32 * nbk;
#pragma unroll 8
    for (int i = 0; i < 32; ++i) { const int kk = 2 * i + (lane >> 5); scr[kk * 33 + (lane & 31)] = W[(size_t)(k0 + kk) * N + n0 + (lane & 31)]; }
    LDS_WAIT(); asm volatile("" ::: "memory");
    const int c = lane & 7;
#pragma unroll
    for (int j = 0; j < 4; ++j) { const int n = (lane >> 3) + 8 * j; const LAS float* s = scr + (8 * c) * 33 + n;
        u32x4 o; o.x = pk2(s[0 * 33], s[1 * 33]); o.y = pk2(s[2 * 33], s[3 * 33]); o.z = pk2(s[4 * 33], s[5 * 33]); o.w = pk2(s[6 * 33], s[7 * 33]);
        const int nn = n0 + n; const int drow = perm ? (nn < FF ? 8 * (nn >> 2) + (nn & 3) : 8 * ((nn - FF) >> 2) + 4 + ((nn - FF) & 3)) : nn;
        *(u32x4*)(WT + (size_t)(row_base + drow) * ldk + koff + k0 + 8 * c) = o; }
    LDS_WAIT(); asm volatile("" ::: "memory");
}
__device__ __forceinline__ void phase0(const Args& a, LAS unsigned char* lds, int tid, int lane, int wave) {
    unsigned char* ws = a.ws;
    const int G = gridDim.x, bx = blockIdx.x;
    if (bx < 96) {
        LAS float* red = (LAS float*)lds; LAS float* scs = (LAS float*)(lds + 32768);
        const float* c = a.in[1]; const float* cc = a.in[3]; const float* wm = a.in[4]; const float* bm = a.in[5]; float* mod = (float*)(ws + WS_MOD);
        for (int i = tid; i < 9 * 1024; i += 512) { const float v = i < 8192 ? c[i] : cc[i - 8192]; scs[i] = v * sigm(v); }
        __syncthreads();
        for (int cgp = bx; cgp < 96; cgp += G) {
            const int col = cgp * 64 + lane; float acc[9];
#pragma unroll
            for (int r = 0; r < 9; ++r) acc[r] = 0.f;
            for (int k = wave * 128; k < wave * 128 + 128; ++k) { const float wv = wm[(size_t)k * MODN + col];
#pragma unroll
                for (int r = 0; r < 9; ++r) acc[r] += scs[r * 1024 + k] * wv; }
#pragma unroll
            for (int r = 0; r < 9; ++r) red[(wave * 9 + r) * 64 + lane] = acc[r];
            __syncthreads();
            for (int idx = tid; idx < 576; idx += 512) { const int r = idx >> 6, l = idx & 63; float s = bm[cgp * 64 + l];
#pragma unroll
                for (int w = 0; w < 8; ++w) s += red[(w * 9 + r) * 64 + l];
                mod[r * MODN + cgp * 64 + l] = s; }
            __syncthreads();
        }
    }
    {
        LAS float* scr = (LAS float*)(lds + wave * 16384);
        const int gw = bx * 8 + wave, NGW = G * 8;
        constexpr int I_IN = 16 * (NIN / 32), I_OUT = 16 * 32, I_FFI = 16 * (2 * FF / 32), I_FFO = (FF / 64) * 32, I_L = 16, I_G = 32;
        constexpr int NITEMS = I_IN + I_OUT + I_FFI + I_FFO + 4 * I_L + I_G;
        bf16* win = (bf16*)(ws + WS_WIN); bf16* wout = (bf16*)(ws + WS_WOUT); bf16* wffi = (bf16*)(ws + WS_WFFI); bf16* wffo = (bf16*)(ws + WS_WFFO); bf16* wlo = (bf16*)(ws + WS_WLORA);
        const bool late_ride = G == 256;
        for (int it = gw; it < NITEMS; it += NGW) {
            int r = it;
            if (late_ride && r >= I_IN && r < I_IN + I_OUT + I_FFI + I_FFO) continue;
            if (r < I_IN) { transpose_item(a.in[7], NIN, win, DM, 0, 0, false, scr, r, lane); continue; } r -= I_IN;
            if (r < I_OUT) { transpose_item(a.in[22], DM, wout, DM, 0, 0, false, scr, r, lane); continue; } r -= I_OUT;
            if (r < I_FFI) { transpose_item(a.in[24], 2 * FF, wffi, DM, 0, 0, true, scr, r, lane); continue; } r -= I_FFI;
            if (r < I_FFO) { transpose_item(a.in[25], DM, wffo, FF, 0, 0, false, scr, r, lane); continue; } r -= I_FFO;
            if (r < 2 * I_L) { const int d = r / I_L; transpose_item(a.in[10] + (size_t)d * 64 * 512, 512, wlo, KLB, 64 * d, 512 * d, false, scr, r % I_L, lane); continue; } r -= 2 * I_L;
            if (r < 2 * I_L) { const int d = r / I_L; transpose_item(a.in[12] + (size_t)d * 64 * 512, 512, wlo, KLB, 64 * d, 1024 + 512 * d, false, scr, r % I_L, lane); continue; } r -= 2 * I_L;
            transpose_item(a.in[13], 512, wlo, KLB, 0, 2048, false, scr, r, lane);
        }
        const int gt = bx * 512 + tid, NT = G * 512;
        const u32x4 z4 = (u32x4){0u, 0u, 0u, 0u};
        for (int i = gt; i < (NINP - NIN) * DM / 8; i += NT) *(u32x4*)(win + (size_t)NIN * DM + (size_t)i * 8) = z4;
        for (int i = gt; i < 2048 * 8; i += NT) { const int n = i >> 3, kc = i & 7, blk = n >> 9;
            *(u32x4*)(wlo + (size_t)n * KLB + ((blk & 1) ? 0 : 64) + 8 * kc) = z4; }
    }
}
struct NormRow { f32x4 v[4]; };
__device__ __forceinline__ NormRow norm_load(const float* src, int lane) { NormRow r; const f32x4* xr = (const f32x4*)src + lane;
#pragma unroll
    for (int j = 0; j < 4; ++j) r.v[j] = xr[64 * j];
    return r; }
template <int MODE> __device__ __forceinline__ void norm_finish(const NormRow& r, const float* g, const float* sh, const float* sc, void* dst, int lane) {
    float s = 0.f;
#pragma unroll
    for (int j = 0; j < 4; ++j) s += (r.v[j].x * r.v[j].x + r.v[j].y * r.v[j].y) + (r.v[j].z * r.v[j].z + r.v[j].w * r.v[j].w);
    const float rstd = rsqrtf(wave_sum(s) * (1.f / DM) + 1e-6f);
#pragma unroll
    for (int j = 0; j < 4; ++j) { const int idx = 4 * lane + 256 * j; f32x4 y = r.v[j] * rstd * *(const f32x4*)(g + idx);
        if (MODE == 0) { y = y * (*(const f32x4*)(sc + idx) + 1.0f) + *(const f32x4*)(sh + idx);
            u32x2 w; w.x = pk2(y.x, y.y); w.y = pk2(y.z, y.w); *(u32x2*)((bf16*)dst + idx) = w; }
        else *(f32x4*)((float*)dst + idx) = y; }
}
struct NormRowB { u32x4 v[2]; };
__device__ __forceinline__ NormRowB normb_load(const bf16* src, int lane) { NormRowB r; r.v[0] = *(const u32x4*)(src + 8 * lane); r.v[1] = *(const u32x4*)(src + 512 + 8 * lane); return r; }
__device__ __forceinline__ void normb_finish(const NormRowB& r, const float* g, const float* sh, const float* sc, bf16* dst, int lane) {
    float x[2][8]; unpack8(r.v[0], x[0]); unpack8(r.v[1], x[1]); float s = 0.f;
#pragma unroll
    for (int j = 0; j < 2; ++j)
#pragma unroll
        for (int e = 0; e < 8; ++e) s += x[j][e] * x[j][e];
    const float rstd = rsqrtf(wave_sum(s) * (1.f / DM) + 1e-6f);
#pragma unroll
    for (int j = 0; j < 2; ++j) { const int idx = 8 * lane + 512 * j; float y[8];
        const f32x4 g0 = *(const f32x4*)(g + idx), g1 = *(const f32x4*)(g + idx + 4), c0 = *(const f32x4*)(sc + idx), c1 = *(const f32x4*)(sc + idx + 4), h0 = *(const f32x4*)(sh + idx), h1 = *(const f32x4*)(sh + idx + 4);
#pragma unroll
        for (int e = 0; e < 4; ++e) { y[e] = x[j][e] * rstd * g0[e] * (c0[e] + 1.0f) + h0[e]; y[4 + e] = x[j][4 + e] * rstd * g1[e] * (c1[e] + 1.0f) + h1[e]; }
        *(u32x4*)(dst + idx) = pack8(y); }
}
__device__ __forceinline__ void normb_final(const NormRowB& r, const float* g, float* dst, int lane) {
    float x[2][8]; unpack8(r.v[0], x[0]); unpack8(r.v[1], x[1]); float s = 0.f;
#pragma unroll
    for (int j = 0; j < 2; ++j)
#pragma unroll
        for (int e = 0; e < 8; ++e) s += x[j][e] * x[j][e];
    const float rstd = rsqrtf(wave_sum(s) * (1.f / DM) + 1e-6f);
#pragma unroll
    for (int j = 0; j < 2; ++j) { const int idx = 8 * lane + 512 * j; const f32x4 g0 = *(const f32x4*)(g + idx), g1 = *(const f32x4*)(g + idx + 4);
        *(f32x4*)(dst + idx) = (f32x4){x[j][0] * rstd * g0[0], x[j][1] * rstd * g0[1], x[j][2] * rstd * g0[2], x[j][3] * rstd * g0[3]};
        *(f32x4*)(dst + idx + 4) = (f32x4){x[j][4] * rstd * g1[0], x[j][5] * rstd * g1[1], x[j][6] * rstd * g1[2], x[j][7] * rstd * g1[3]}; }
}
__device__ __forceinline__ void phase_la(const bf16* P, const float* mu, bf16* LA, int lane, int gw, int NGW) {
    for (int R = gw; R < MT; R += NGW) {
        if (lane < 48) {
            const int col = PC_LORA + 8 * lane; const Nb4 nb = neighbors(R);
            const Raw5 rw = load_raw5(P, R, nb, col); float x[8]; xm8(rw, mu + col, x);
            if (lane < 16) {
#pragma unroll
                for (int e = 0; e < 8; ++e) x[e] = 1.0f - 2.0f * __builtin_amdgcn_rcpf(__expf(2.0f * x[e]) + 1.0f); }
            else if (lane >= 32) {
#pragma unroll
                for (int e = 0; e < 8; ++e) x[e] = sigm(x[e]); }
            *(u32x4*)(LA + (size_t)R * KLO + 8 * lane) = pack8(x);
        }
    }
}
__device__ __forceinline__ int gla_row(int b, int dir, int slot, int i) {
    if (slot < 4) { const int base = dir ? (192 - 64 * slot) : 64 * slot; return ML + b * CTXL + base + i; }
    const int j = slot - 4; const int col = dir ? 63 - j : j; return b * TL + i * 64 + col;
}
constexpr int GL_LG = 0, GL_QS = 16384, GL_KS = 25600, GL_VT = 34816, GL_AM = 53248, GL_SSQ = 62464, GL_TOT = 64512, GL_A2S = 66560, GLP = 72;
struct GlaRaw { u32x4 l0, l1, q, k, v0, v1; };
template <bool NEEDQ> __device__ __forceinline__ GlaRaw gla_prefetch(const bf16* P, int b, int h, int dir, int slot, int tid) {
    const int i = tid >> 3, t8 = tid & 7; const bf16* row = P + (size_t)gla_row(b, dir, slot, i) * NINP; GlaRaw g;
    g.l0 = *(const u32x4*)(row + PC_GLF + 16 * dir); g.l1 = *(const u32x4*)(row + PC_GLF + 16 * dir + 8);
    g.k = *(const u32x4*)(row + PC_GK + h * 64 + 8 * t8); g.q = NEEDQ ? *(const u32x4*)(row + PC_GQ + h * 64 + 8 * t8) : g.k;
    g.v0 = *(const u32x4*)(row + PC_GV + h * 128 + 16 * t8); g.v1 = *(const u32x4*)(row + PC_GV + h * 128 + 16 * t8 + 8);
    return g;
}
__device__ __forceinline__ void gla_stage_a2(const float* ga2, LAS float* a2s, int tid) {
    for (int idx = tid * 4; idx < 8192; idx += 2048) { const int dh = idx >> 10, r = (idx >> 6) & 15, d = idx & 63;
        *(LAS f32x4*)(a2s + idx) = *(const f32x4*)(ga2 + (size_t)(dh >> 2) * 4096 + r * 256 + (dh & 3) * 64 + d); }
    __syncthreads();
}
__device__ __forceinline__ void gla_gates(const u32x4& l0, const u32x4& l1, const LAS float* a2s, const float* gab, int h, int dir, LAS float* lg, int tid) {
    const int i = tid >> 3, d0 = 8 * (tid & 7);
    float lr[16]; { float t0[8], t1[8]; unpack8(l0, t0); unpack8(l1, t1);
#pragma unroll
        for (int e = 0; e < 8; ++e) { lr[e] = t0[e]; lr[8 + e] = t1[e]; } }
    const LAS float* a2p = a2s + (dir * 4 + h) * 1024 + d0; const float* abp = gab + dir * 256 + h * 64 + d0;
    f32x4 x0 = *(const f32x4*)abp, x1 = *(const f32x4*)(abp + 4);
#pragma unroll
    for (int r = 0; r < 16; ++r) { x0 += *(const LAS f32x4*)(a2p + r * 64) * lr[r]; x1 += *(const LAS f32x4*)(a2p + r * 64 + 4) * lr[r]; }
    f32x4 y0, y1;
#pragma unroll
    for (int e = 0; e < 4; ++e) { y0[e] = logsigm(x0[e]) * 0.0625f; y1[e] = logsigm(x1[e]) * 0.0625f; }
    *(LAS f32x4*)(lg + i * 64 + d0) = y0; *(LAS f32x4*)(lg + i * 64 + d0 + 4) = y1;
    __syncthreads();
    {
        LAS float* tot = lg + (GL_TOT / 4); const int g = __builtin_amdgcn_readfirstlane(tid >> 6), d = tid & 63; float pr[8]; float run = 0.f;
        if (dir == 0) {
#pragma unroll
            for (int r = 0; r < 8; ++r) { run += lg[(8 * g + r) * 64 + d]; pr[r] = run; } }
        else {
#pragma unroll
            for (int r = 7; r >= 0; --r) { run += lg[(8 * g + r) * 64 + d]; pr[r] = run; } }
        tot[g * 64 + d] = run;
        __syncthreads();
        float off = 0.f;
#pragma unroll
        for (int gg = 0; gg < 8; ++gg) { const float tv = tot[gg * 64 + d]; off += ((dir == 0) ? (gg < g) : (gg > g)) ? tv : 0.f; }
#pragma unroll
        for (int r = 0; r < 8; ++r) lg[(8 * g + r) * 64 + d] = pr[r] + off;
    }
    __syncthreads();
}
__device__ __forceinline__ void gla_store_vT(const u32x4& v0, const u32x4& v1, LAS bf16* vT, int tid) {
    const int j = tid >> 3, e0 = 16 * (tid & 7);
    const unsigned w[8] = {v0.x, v0.y, v0.z, v0.w, v1.x, v1.y, v1.z, v1.w};
    const int jp = j ^ (8 * (tid & 7));
#pragma unroll
    for (int q = 0; q < 8; ++q) { vT[(e0 + 2 * q) * GLP + jp] = (bf16)(w[q] & 0xffffu); vT[(e0 + 2 * q + 1) * GLP + jp] = (bf16)(w[q] >> 16); }
}
__device__ __forceinline__ void gla_pass_a(const bf16* P, const float* ga2, const float* gab, bf16* GS, float* GAM, LAS unsigned char* lds, int tid, int lane, int wave) {
    LAS float* lg = (LAS float*)(lds + GL_LG); LAS bf16* kdT = (LAS bf16*)(lds + GL_KS); LAS bf16* vT = (LAS bf16*)(lds + GL_VT); LAS float* a2s = (LAS float*)(lds + GL_A2S);
    constexpr int NU = NB * 4 * 2 * NSLOT; const int G = gridDim.x;
    gla_stage_a2(ga2, a2s, tid);
    GlaRaw nxt;
    { const int unit = blockIdx.x; if (unit < NU) nxt = gla_prefetch<false>(P, unit / (8 * NSLOT), (unit / (2 * NSLOT)) & 3, (unit / NSLOT) & 1, unit % NSLOT, tid); }
    for (int unit = blockIdx.x; unit < NU; unit += G) {
        const int slot = unit % NSLOT, dir = (unit / NSLOT) & 1, h = (unit / (2 * NSLOT)) & 3;
        const GlaRaw cur = nxt;
        gla_gates(cur.l0, cur.l1, a2s, gab, h, dir, lg, tid);
        const int lastrow = dir ? 0 : 63;
        { const int j = tid >> 3, d0 = 8 * (tid & 7);
          float k[8]; unpack8(cur.k, k);
#pragma unroll
          for (int e = 0; e < 8; ++e) { const float v = k[e] * __expf(lg[lastrow * 64 + d0 + e] - lg[j * 64 + d0 + e]); kdT[(d0 + e) * GLP + (j ^ d0)] = (bf16)(pk2(v, 0.f) & 0xffffu); } }
        gla_store_vT(cur.v0, cur.v1, vT, tid);
        if (tid < 64) GAM[(size_t)unit * 64 + tid] = __expf(lg[lastrow * 64 + tid]);
        { const int un = unit + G; if (un < NU) nxt = gla_prefetch<false>(P, un / (8 * NSLOT), (un / (2 * NSLOT)) & 3, (un / NSLOT) & 1, un % NSLOT, tid); }
        __syncthreads();
        f32x4 acc[4];
#pragma unroll
        for (int m = 0; m < 4; ++m) acc[m] = (f32x4){0.f, 0.f, 0.f, 0.f};
#pragma unroll
        for (int ks = 0; ks < 2; ++ks) { const bf16x8 bfr = *(const LAS bf16x8*)(vT + (16 * wave + (lane & 15)) * GLP + ((ks * 32 + (lane >> 4) * 8) ^ (8 * wave)));
#pragma unroll
            for (int m = 0; m < 4; ++m) { const bf16x8 afr = *(const LAS bf16x8*)(kdT + (16 * m + (lane & 15)) * GLP + ((ks * 32 + (lane >> 4) * 8) ^ (8 * (2 * m + ((lane >> 3) & 1)))));
                acc[m] = __builtin_amdgcn_mfma_f32_16x16x32_bf16(afr, bfr, acc[m], 0, 0, 0); } }
        bf16* dst = GS + (size_t)unit * 8192 + (size_t)(16 * wave + (lane & 15)) * 64 + (lane >> 4) * 4;
#pragma unroll
        for (int m = 0; m < 4; ++m) { u32x2 w; w.x = pk2(acc[m][0], acc[m][1]); w.y = pk2(acc[m][2], acc[m][3]); *(u32x2*)(dst + 16 * m) = w; }
        __syncthreads();
    }
}
__device__ __forceinline__ void gla_pass_b(bf16* GS, const float* GAM, int tid) {
    const int gt = blockIdx.x * 512 + tid;
    for (int wi = gt; wi < 64 * 2048; wi += gridDim.x * 512) {
        const int chain = wi >> 11, off = (wi & 2047) * 4, d = off & 63;
        bf16* base = GS + (size_t)chain * NSLOT * 8192 + off; const float* gb = GAM + (size_t)chain * NSLOT * 64 + d;
        f32x4 S = (f32x4){0.f, 0.f, 0.f, 0.f};
#pragma unroll 1
        for (int s0 = 0; s0 < NSLOT; s0 += 17) {
            u32x2 kv[17]; f32x4 gm[17];
#pragma unroll
            for (int q = 0; q < 17; ++q) { kv[q] = *(const u32x2*)(base + (size_t)(s0 + q) * 8192); gm[q] = *(const f32x4*)(gb + (s0 + q) * 64); }
#pragma unroll
            for (int q = 0; q < 17; ++q) { u32x2 o; o.x = pk2(S[0], S[1]); o.y = pk2(S[2], S[3]); *(u32x2*)(base + (size_t)(s0 + q) * 8192) = o;
                const f32x4 kf = (f32x4){bflo(kv[q].x), bfhi(kv[q].x), bflo(kv[q].y), bfhi(kv[q].y)}; S = gm[q] * S + kf; }
        }
    }
}
constexpr int C2_LG = 0, C2_QS = 32768, C2_KS = 51200, C2_VT = 69632, C2_AM = 88064, C2_SSQ = 97280, C2_TOT = 99328, C2_A2S = 103424;
struct GlaRaw2 { u32x4 lf0, lf1, lb0, lb1, q, k, v0, v1; };
__device__ __forceinline__ GlaRaw2 gla_prefetch2(const bf16* P, int b, int h, int j, int tid) {
    const int i = tid >> 3, t8 = tid & 7; const bf16* row = P + (size_t)(b * TL + i * 64 + j) * NINP; GlaRaw2 g;
    g.lf0 = *(const u32x4*)(row + PC_GLF); g.lf1 = *(const u32x4*)(row + PC_GLF + 8); g.lb0 = *(const u32x4*)(row + PC_GLF + 16); g.lb1 = *(const u32x4*)(row + PC_GLF + 24);
    g.q = *(const u32x4*)(row + PC_GQ + h * 64 + 8 * t8); g.k = *(const u32x4*)(row + PC_GK + h * 64 + 8 * t8);
    g.v0 = *(const u32x4*)(row + PC_GV + h * 128 + 16 * t8); g.v1 = *(const u32x4*)(row + PC_GV + h * 128 + 16 * t8 + 8);
    return g;
}
template <int DIR> __device__ __forceinline__ void gates_x(const u32x4& l0, const u32x4& l1, const LAS float* a2s, const float* gab, int h, LAS float* lg, int tid) {
    const int i = tid >> 3, d0 = 8 * (tid & 7);
    float lr[16]; { float t0[8], t1[8]; unpack8(l0, t0); unpack8(l1, t1);
#pragma unroll
        for (int e = 0; e < 8; ++e) { lr[e] = t0[e]; lr[8 + e] = t1[e]; } }
    const LAS float* a2p = a2s + (DIR * 4 + h) * 1024 + d0; const float* abp = gab + DIR * 256 + h * 64 + d0;
    f32x4 x0 = *(const f32x4*)abp, x1 = *(const f32x4*)(abp + 4);
#pragma unroll
    for (int r = 0; r < 16; ++r) { x0 += *(const LAS f32x4*)(a2p + r * 64) * lr[r]; x1 += *(const LAS f32x4*)(a2p + r * 64 + 4) * lr[r]; }
    f32x4 y0, y1;
#pragma unroll
    for (int e = 0; e < 4; ++e) { y0[e] = logsigm(x0[e]) * 0.0625f; y1[e] = logsigm(x1[e]) * 0.0625f; }
    *(LAS f32x4*)(lg + i * 64 + d0) = y0; *(LAS f32x4*)(lg + i * 64 + d0 + 4) = y1;
}
template <int DIR> __device__ __forceinline__ void gates_s1(const LAS float* lg, LAS float* tot, int g, int d, float (&pr)[8]) {
    float run = 0.f;
    if (DIR == 0) {
#pragma unroll
        for (int r = 0; r < 8; ++r) { run += lg[(8 * g + r) * 64 + d]; pr[r] = run; } }
    else {
#pragma unroll
        for (int r = 7; r >= 0; --r) { run += lg[(8 * g + r) * 64 + d]; pr[r] = run; } }
    tot[g * 64 + d] = run;
}
template <int DIR> __device__ __forceinline__ void gates_s2(LAS float* lg, const LAS float* tot, int g, int d, const float (&pr)[8]) {
    float off = 0.f;
#pragma unroll
    for (int gg = 0; gg < 8; ++gg) { const float tv = tot[gg * 64 + d]; off += ((DIR == 0) ? (gg < g) : (gg > g)) ? tv : 0.f; }
#pragma unroll
    for (int r = 0; r < 8; ++r) lg[(8 * g + r) * 64 + d] = pr[r] + off;
}
struct AsmS1 { Raw5 r, k; u32x4 a0, a1; };
struct AsmS2 { Raw5 v; u32x4 g, y0, y1; };
struct AsmCtx { const bf16* P; const bf16* WAG; const bf16* Y; const float* mu; const float* kaw; const float* rkw; const float* lnw; const float* lnb; bf16* Mx; };
__device__ __forceinline__ AsmS1 asm_s1_load(const AsmCtx& C, int R, int lane) { const int c = 8 * lane; const Nb4 nb = neighbors(R); AsmS1 x;
    x.r = load_raw5(C.P, R, nb, c); x.k = load_raw5(C.P, R, nb, PC_K + c); x.a0 = *(const u32x4*)(C.WAG + (size_t)R * NLO + 1024 + c); x.a1 = *(const u32x4*)(C.WAG + (size_t)R * NLO + 1536 + c); return x; }
__device__ __forceinline__ float asm_s1_finish(const AsmCtx& C, const AsmS1& x, int lane) { const int c = 8 * lane; float r[8], k[8], a0[8], a1[8];
    xm8(x.r, C.mu + c, r); xm8(x.k, C.mu + PC_K + c, k); unpack8(x.a0, a0); unpack8(x.a1, a1); float bs = 0.f;
#pragma unroll
    for (int q = 0; q < 8; ++q) bs += r[q] * (k[q] * (2.0f + (a0[q] + a1[q] - 2.0f) * C.kaw[c + q])) * C.rkw[c + q];
    return red8(bs); }
__device__ __forceinline__ AsmS2 asm_s2_load(const AsmCtx& C, int R, int lane) { const int c = 8 * lane; const Nb4 nb = neighbors(R); AsmS2 x;
    x.v = load_raw5(C.P, R, nb, PC_V + c); x.g = *(const u32x4*)(C.WAG + (size_t)R * NLO + 2048 + c); x.y0 = *(const u32x4*)(C.Y + (size_t)R * 512 + c); x.y1 = *(const u32x4*)(C.Y + ((size_t)ML + R) * 512 + c); return x; }
__device__ __forceinline__ void asm_s2_finish(const AsmCtx& C, const AsmS2& x, float bs, int R, int lane) { const int c = 8 * lane; float v[8], g[8], y[8], yb[8];
    xm8(x.v, C.mu + PC_V + c, v); unpack8(x.g, g); unpack8(x.y0, y); unpack8(x.y1, yb);
    float sm = 0.f;
#pragma unroll
    for (int q = 0; q < 8; ++q) { y[q] += yb[q]; sm += y[q]; }
    const float mean = red8(sm) * (1.f / 64.f); float sq = 0.f;
#pragma unroll
    for (int q = 0; q < 8; ++q) { const float d = y[q] - mean; sq += d * d; }
    const float rstd = rsqrtf(red8(sq) * (1.f / 64.f) + 64e-5f); float o[8];
#pragma unroll
    for (int q = 0; q < 8; ++q) o[q] = ((y[q] - mean) * rstd * C.lnw[c + q] + C.lnb[c + q] + bs * v[q]) * g[q];
    *(u32x4*)(C.Mx + (size_t)R * DM + c) = pack8(o); }
__device__ __forceinline__ void gla_pass_c(const bf16* P, const float* ga2, const float* gab, const float* gain, const bf16* GS, bf16* Mx, LAS unsigned char* lds, int tid, int lane, int wave, const AsmCtx& AC, int gw, int NGW) {
    LAS float* lg0 = (LAS float*)(lds + C2_LG); LAS float* lg1 = lg0 + 4096; LAS bf16* qs0 = (LAS bf16*)(lds + C2_QS); LAS bf16* qs1 = qs0 + 64 * GLP;
    LAS bf16* ks0 = (LAS bf16*)(lds + C2_KS); LAS bf16* ks1 = ks0 + 64 * GLP; LAS bf16* vT = (LAS bf16*)(lds + C2_VT); LAS bf16* am = (LAS bf16*)(lds + C2_AM);
    LAS float* ssq = (LAS float*)(lds + C2_SSQ); LAS float* tot0 = (LAS float*)(lds + C2_TOT); LAS float* tot1 = tot0 + 512; LAS float* a2s = (LAS float*)(lds + C2_A2S);
    constexpr int NU = NB * 64 * 4; const int G = gridDim.x;
    gla_stage_a2(ga2, a2s, tid);
    const int sg = __builtin_amdgcn_readfirstlane(tid >> 6), sd = tid & 63;
    GlaRaw2 nxt;
    { const int unit = blockIdx.x; if (unit < NU) nxt = gla_prefetch2(P, unit >> 8, unit & 3, (unit >> 2) & 63, tid); }
    int Ras = gw;
    for (int unit = blockIdx.x; unit < NU; unit += G) {
        const int h = unit & 3, j = (unit >> 2) & 63, b = unit >> 8;
        const int RA = Ras, RB = Ras + NGW; const bool hasA = RA < ML, hasB = RB < ML; const int RAc = hasA ? RA : gw, RBc = hasB ? RB : gw; Ras += 2 * NGW;
        const AsmS1 s1A = asm_s1_load(AC, RAc, lane);
        const int e = 16 * wave + (lane & 15);
        float ogv[4][4];
#pragma unroll
        for (int m = 0; m < 4; ++m)
#pragma unroll
            for (int jj = 0; jj < 4; ++jj) { const int i = 16 * m + (lane >> 4) * 4 + jj; ogv[m][jj] = bf1(P[(size_t)(b * TL + i * 64 + j) * NINP + PC_GOG + h * 128 + e]); }
        const GlaRaw2 cur = nxt;
        const size_t su0 = ((size_t)((b * 4 + h) * 2 + 0) * NSLOT + 4 + j) * 8192, su1 = ((size_t)((b * 4 + h) * 2 + 1) * NSLOT + 4 + (63 - j)) * 8192;
        const bf16x8 bs00 = *(const bf16x8*)(GS + su0 + (size_t)e * 64 + (lane >> 4) * 8), bs01 = *(const bf16x8*)(GS + su0 + (size_t)e * 64 + 32 + (lane >> 4) * 8);
        const bf16x8 bs10 = *(const bf16x8*)(GS + su1 + (size_t)e * 64 + (lane >> 4) * 8), bs11 = *(const bf16x8*)(GS + su1 + (size_t)e * 64 + 32 + (lane >> 4) * 8);
        gates_x<0>(cur.lf0, cur.lf1, a2s, gab, h, lg0, tid); gates_x<1>(cur.lb0, cur.lb1, a2s, gab, h, lg1, tid);
        __syncthreads();
        const float bsA = asm_s1_finish(AC, s1A, lane); const AsmS2 s2A = asm_s2_load(AC, RAc, lane);
        float pr0[8], pr1[8];
        gates_s1<0>(lg0, tot0, sg, sd, pr0); gates_s1<1>(lg1, tot1, sg, sd, pr1);
        __syncthreads();
        gates_s2<0>(lg0, tot0, sg, sd, pr0); gates_s2<1>(lg1, tot1, sg, sd, pr1);
        __syncthreads();
        { const int i = tid >> 3, d0 = 8 * (tid & 7);
          float q[8], k[8], q1[8], k1[8]; unpack8(cur.q, q); unpack8(cur.k, k);
#pragma unroll
          for (int ee = 0; ee < 8; ++ee) { const float b0 = lg0[i * 64 + d0 + ee], b1 = lg1[i * 64 + d0 + ee]; const float qq = q[ee] * 0.125f, kk = k[ee];
              q[ee] = qq * __expf(b0); k[ee] = kk * __expf(-b0); q1[ee] = qq * __expf(b1); k1[ee] = kk * __expf(-b1); }
          *(LAS u32x4*)(qs0 + i * GLP + d0) = pack8(q); *(LAS u32x4*)(ks0 + i * GLP + d0) = pack8(k);
          *(LAS u32x4*)(qs1 + i * GLP + d0) = pack8(q1); *(LAS u32x4*)(ks1 + i * GLP + d0) = pack8(k1); }
        gla_store_vT(cur.v0, cur.v1, vT, tid);
        { const int un = unit + G; if (un < NU) nxt = gla_prefetch2(P, un >> 8, un & 3, (un >> 2) & 63, tid); }
        __syncthreads();
        if (hasA) asm_s2_finish(AC, s2A, bsA, RAc, lane);
        const AsmS1 s1B = asm_s1_load(AC, RBc, lane);
        { const int mi = wave >> 1;
#pragma unroll
          for (int t = 0; t < 2; ++t) { const int nj = 2 * (wave & 1) + t; f32x4 acc0 = (f32x4){0.f, 0.f, 0.f, 0.f}, acc1 = acc0;
#pragma unroll
              for (int ks = 0; ks < 2; ++ks) { const int ao = (16 * mi + (lane & 15)) * GLP + ks * 32 + (lane >> 4) * 8, bo = (16 * nj + (lane & 15)) * GLP + ks * 32 + (lane >> 4) * 8;
                  acc0 = __builtin_amdgcn_mfma_f32_16x16x32_bf16(*(const LAS bf16x8*)(qs0 + ao), *(const LAS bf16x8*)(ks0 + bo), acc0, 0, 0, 0);
                  acc1 = __builtin_amdgcn_mfma_f32_16x16x32_bf16(*(const LAS bf16x8*)(qs1 + ao), *(const LAS bf16x8*)(ks1 + bo), acc1, 0, 0, 0); }
              const int cj = 16 * nj + (lane & 15);
#pragma unroll
              for (int jj = 0; jj < 4; ++jj) { const int ri = 16 * mi + (lane >> 4) * 4 + jj;
                  const float av = (cj <= ri ? acc0[jj] : 0.f) + (cj >= ri ? acc1[jj] : 0.f);
                  am[ri * GLP + cj] = (bf16)(pk2(av, 0.f) & 0xffffu); } } }
        __syncthreads();
        const float bsB = asm_s1_finish(AC, s1B, lane); const AsmS2 s2B = asm_s2_load(AC, RBc, lane);
        f32x4 oacc[4];
#pragma unroll
        for (int m = 0; m < 4; ++m) oacc[m] = (f32x4){0.f, 0.f, 0.f, 0.f};
#pragma unroll
        for (int ks = 0; ks < 2; ++ks) {
            const bf16x8 bv = *(const LAS bf16x8*)(vT + (16 * wave + (lane & 15)) * GLP + ((ks * 32 + (lane >> 4) * 8) ^ (8 * wave)));
            const bf16x8 b0 = ks ? bs01 : bs00, b1 = ks ? bs11 : bs10;
#pragma unroll
            for (int m = 0; m < 4; ++m) { const int ao = (16 * m + (lane & 15)) * GLP + ks * 32 + (lane >> 4) * 8;
                oacc[m] = __builtin_amdgcn_mfma_f32_16x16x32_bf16(*(const LAS bf16x8*)(am + ao), bv, oacc[m], 0, 0, 0);
                oacc[m] = __builtin_amdgcn_mfma_f32_16x16x32_bf16(*(const LAS bf16x8*)(qs0 + ao), b0, oacc[m], 0, 0, 0);
                oacc[m] = __builtin_amdgcn_mfma_f32_16x16x32_bf16(*(const LAS bf16x8*)(qs1 + ao), b1, oacc[m], 0, 0, 0); } }
#pragma unroll
        for (int m = 0; m < 4; ++m)
#pragma unroll
            for (int jj = 0; jj < 4; ++jj) { const float sq = red16(oacc[m][jj] * oacc[m][jj]); if ((lane & 15) == 0) ssq[wave * 64 + 16 * m + (lane >> 4) * 4 + jj] = sq; }
        __syncthreads();
        if (hasB) asm_s2_finish(AC, s2B, bsB, RBc, lane);
        const float gn = gain[e];
#pragma unroll
        for (int m = 0; m < 4; ++m)
#pragma unroll
            for (int jj = 0; jj < 4; ++jj) { const int i = 16 * m + (lane >> 4) * 4 + jj; float tt = 0.f;
#pragma unroll
                for (int w = 0; w < 8; ++w) tt += ssq[w * 64 + i];
                const int R = b * TL + i * 64 + j; const float og = ogv[m][jj];
                const float val = oacc[m][jj] * rsqrtf(tt * (1.f / 128.f) + 1e-5f) * gn * (og * sigm(og));
                Mx[(size_t)R * DM + 512 + h * 128 + e] = (bf16)(pk2(val, 0.f) & 0xffffu); }
        __syncthreads();
    }
    for (; Ras < ML; Ras += NGW) { const AsmS1 a1 = asm_s1_load(AC, Ras, lane); const float bb = asm_s1_finish(AC, a1, lane); const AsmS2 a2 = asm_s2_load(AC, Ras, lane); asm_s2_finish(AC, a2, bb, Ras, lane); }
}
struct RwRaw { Raw5 r, k, v; u32x4 e, a; };
__device__ __forceinline__ int rw_row(int b, int dir, int s, int j) {
    if (s < 4) return ML + b * CTXL + (dir ? 192 - 64 * s : 64 * s) + j;
    const int gr = dir ? 63 - (s - 4) : s - 4; return b * TL + gr * 64 + j;
}
__device__ __forceinline__ int rw_hrow(int b, int dir, int hc, int jj) { const int i = 32 * (hc & 1) + jj; return rw_row(b, dir, hc >> 1, dir ? 63 - i : i); }
__device__ __forceinline__ RwRaw rw_load(const bf16* P, const bf16* WAG, int b, int h, int dir, int hc, int t) {
    const int jj = t >> 3, ch0 = 8 * (t & 7); const int R = rw_hrow(b, dir, hc, jj); const Nb4 nb = neighbors(R);
    RwRaw x; x.r = load_raw5(P, R, nb, h * 64 + ch0); x.k = load_raw5(P, R, nb, PC_K + h * 64 + ch0); x.v = load_raw5(P, R, nb, PC_V + h * 64 + ch0);
    x.e = *(const u32x4*)(WAG + (size_t)R * NLO + dir * 512 + h * 64 + ch0); x.a = *(const u32x4*)(WAG + (size_t)R * NLO + 1024 + dir * 512 + h * 64 + ch0);
    return x;
}
__device__ __forceinline__ void rw_features(const RwRaw& x, const float* mu, const float* kkw, const float* kaw, int h, LAS float* feat, int t) {
    const int jj = t >> 3, ch0 = 8 * (t & 7), c = h * 64 + ch0;
    float r[8], k[8], v[8], e[8], a[8]; xm8(x.r, mu + c, r); xm8(x.k, mu + PC_K + c, k); xm8(x.v, mu + PC_V + c, v); unpack8(x.e, e); unpack8(x.a, a);
    const f32x4 kk0 = *(const f32x4*)(kkw + c), kk1 = *(const f32x4*)(kkw + c + 4), ka0 = *(const f32x4*)(kaw + c), ka1 = *(const f32x4*)(kaw + c + 4);
    float kk[8], ss = 0.f;
#pragma unroll
    for (int q = 0; q < 8; ++q) { kk[q] = k[q] * (q < 4 ? kk0[q & 3] : kk1[q & 3]); ss += kk[q] * kk[q]; }
    ss = red8(ss); const float inv = __builtin_amdgcn_rsqf(fmaxf(ss, 1e-24f));
    float w[8], kd[8], bd[8];
#pragma unroll
    for (int q = 0; q < 8; ++q) { const float kav = q < 4 ? ka0[q & 3] : ka1[q & 3]; kk[q] *= inv; w[q] = __expf(-e[q]); kd[q] = k[q] * (1.0f + (a[q] - 1.0f) * kav); bd[q] = kk[q] * a[q]; }
    const int tw = (t >> 3) & 7;
    float rin[8], rex[8];
#pragma unroll
    for (int q = 0; q < 8; ++q) { float cp = w[q];
        const float t1 = __shfl_up(cp, 8); cp = tw >= 1 ? cp * t1 : cp;
        const float t2 = __shfl_up(cp, 16); cp = tw >= 2 ? cp * t2 : cp;
        const float t4 = __shfl_up(cp, 32); cp = tw >= 4 ? cp * t4 : cp;
        const float pv = __shfl_up(cp, 8); rin[q] = cp; rex[q] = tw >= 1 ? pv : 1.0f; }
#pragma unroll
    for (int q = 0; q < 8; ++q) { const float ir = __builtin_amdgcn_rcpf(rin[q]); kk[q] *= rex[q]; bd[q] *= ir; kd[q] *= ir; r[q] *= rin[q]; }
    LAS float* f = feat + jj * 384 + ch0;
    *(LAS f32x4*)(f) = (f32x4){r[0], r[1], r[2], r[3]}; *(LAS f32x4*)(f + 4) = (f32x4){r[4], r[5], r[6], r[7]};
    *(LAS f32x4*)(f + 64) = (f32x4){rin[0], rin[1], rin[2], rin[3]}; *(LAS f32x4*)(f + 68) = (f32x4){rin[4], rin[5], rin[6], rin[7]};
    *(LAS f32x4*)(f + 128) = (f32x4){kd[0], kd[1], kd[2], kd[3]}; *(LAS f32x4*)(f + 132) = (f32x4){kd[4], kd[5], kd[6], kd[7]};
    *(LAS f32x4*)(f + 192) = (f32x4){kk[0], kk[1], kk[2], kk[3]}; *(LAS f32x4*)(f + 196) = (f32x4){kk[4], kk[5], kk[6], kk[7]};
    *(LAS f32x4*)(f + 256) = (f32x4){bd[0], bd[1], bd[2], bd[3]}; *(LAS f32x4*)(f + 260) = (f32x4){bd[4], bd[5], bd[6], bd[7]};
    *(LAS f32x4*)(f + 320) = (f32x4){v[0], v[1], v[2], v[3]}; *(LAS f32x4*)(f + 324) = (f32x4){v[4], v[5], v[6], v[7]};
}
typedef float f32x2 __attribute__((ext_vector_type(2)));
struct RwFeat { f32x2 r[4], kd[4], kk[4], bd[4]; float v; };
#define RW_LD2(dst, fj, off) { const f32x4 t0 = *(const LAS f32x4*)((fj) + (off) + c8), t1 = *(const LAS f32x4*)((fj) + (off) + c8 + 4); \
        dst[0] = (f32x2){t0.x, t0.y}; dst[1] = (f32x2){t0.z, t0.w}; dst[2] = (f32x2){t1.x, t1.y}; dst[3] = (f32x2){t1.z, t1.w}; }
__device__ __forceinline__ RwFeat rw_ldfeat(const LAS float* fj, int c8, int row) {
    RwFeat f;
    RW_LD2(f.kk, fj, 192) RW_LD2(f.bd, fj, 256) RW_LD2(f.kd, fj, 128) RW_LD2(f.r, fj, 0)
    f.v = fj[320 + row]; return f;
}
__device__ __forceinline__ float rw_step(f32x2 (&S)[4], const RwFeat& f) {
    f32x2 pa = S[0] * f.kk[0], pb = S[1] * f.kk[1]; pa = S[2] * f.kk[2] + pa; pb = S[3] * f.kk[3] + pb; pa = pa + pb;
#pragma unroll
    for (int q = 0; q < 4; ++q) S[q] = f.kd[q] * f.v + S[q];
    const float sa = -red8(pa.x + pa.y);
#pragma unroll
    for (int q = 0; q < 4; ++q) S[q] = f.bd[q] * sa + S[q];
    f32x2 ya = S[0] * f.r[0], yb = S[1] * f.r[1]; ya = S[2] * f.r[2] + ya; yb = S[3] * f.r[3] + yb; ya = ya + yb;
    return red8(ya.x + ya.y);
}
__device__ __forceinline__ void rwkv_scan(const bf16* P, const bf16* WAG, const float* mu, const float* kkw, const float* kaw, bf16* Y, LAS unsigned char* lds, int tid, int lane, int wave, bf16* GS, const float* GAM, const float* w_out, const float* w_ffi, const float* w_ffo, unsigned char* ws) {
    LAS float* featb = (LAS float*)lds; LAS float* ybufb = (LAS float*)(lds + 98304);
    constexpr int NHC = 2 * NSLOT;
    for (int unit = blockIdx.x; unit < 256; unit += gridDim.x) {
        const int half = unit & 1, dir = (unit >> 1) & 1, h = (unit >> 2) & 7, b = unit >> 5;
        if (wave >= 4) {
            const int t = tid - 256;
            const int pb0 = blockIdx.x * 256 + t, pb1 = pb0 + 65536; const bool pb_on = gridDim.x == 256;
            bf16* gsA = GS + (size_t)(pb0 >> 11) * NSLOT * 8192 + (pb0 & 2047) * 4; const float* gmA = GAM + (size_t)(pb0 >> 11) * NSLOT * 64 + (((pb0 & 2047) * 4) & 63);
            bf16* gsB = GS + (size_t)(pb1 >> 11) * NSLOT * 8192 + (pb1 & 2047) * 4; const float* gmB = GAM + (size_t)(pb1 >> 11) * NSLOT * 64 + (((pb1 & 2047) * 4) & 63);
            f32x4 SA = (f32x4){0.f, 0.f, 0.f, 0.f}, SB = SA, gA = SA, gB = SA; u32x2 kA = (u32x2){0u, 0u}, kB = kA;
            RwRaw raw = rw_load(P, WAG, b, h, dir, 0, t);
            rw_features(raw, mu, kkw, kaw, h, featb, t);
            raw = rw_load(P, WAG, b, h, dir, 1, t);
            __syncthreads();
#pragma unroll 1
            for (int hc = 0; hc < NHC; ++hc) {
                if (hc + 1 < NHC) rw_features(raw, mu, kkw, kaw, h, featb + ((hc + 1) & 1) * 12288, t);
                if (hc + 2 < NHC) raw = rw_load(P, WAG, b, h, dir, hc + 2, t);
                if (pb_on) { const int sl = hc >> 1;
                    if (!(hc & 1)) { kA = *(const u32x2*)(gsA + (size_t)sl * 8192); gA = *(const f32x4*)(gmA + sl * 64); kB = *(const u32x2*)(gsB + (size_t)sl * 8192); gB = *(const f32x4*)(gmB + sl * 64); }
                    else { u32x2 o; o.x = pk2(SA[0], SA[1]); o.y = pk2(SA[2], SA[3]); *(u32x2*)(gsA + (size_t)sl * 8192) = o; SA = gA * SA + (f32x4){bflo(kA.x), bfhi(kA.x), bflo(kA.y), bfhi(kA.y)};
                           o.x = pk2(SB[0], SB[1]); o.y = pk2(SB[2], SB[3]); *(u32x2*)(gsB + (size_t)sl * 8192) = o; SB = gB * SB + (f32x4){bflo(kB.x), bfhi(kB.x), bflo(kB.y), bfhi(kB.y)}; } }
                if (hc >= 9) { const int jj = t >> 3, q0 = 4 * (t & 7); const int R = rw_hrow(b, dir, hc - 1, jj); const LAS float* yb = ybufb + ((hc - 1) & 1) * 1024 + jj * 32 + q0;
                    u32x2 w; w.x = pk2(yb[0], yb[1]); w.y = pk2(yb[2], yb[3]); *(u32x2*)(Y + ((size_t)dir * ML + R) * 512 + h * 64 + 32 * half + q0) = w; }
                if (pb_on && (hc % 7) == 3) {
                    constexpr int J_OUT = (DM / 8) * (DM / 64), J_FFI = (DM / 8) * (2 * FF / 64), J_FFO = (FF / 8) * (DM / 64);
                    int r = (blockIdx.x * 4 + (wave - 4)) + 1024 * (hc / 7);
                    if (r < J_OUT + J_FFI + J_FFO) {
                        const float* Wsrc = w_out; bf16* Wdst = (bf16*)(ws + WS_WOUT); int Nn = DM, ldk = DM; bool pm = false;
                        if (r >= J_OUT + J_FFI) { r -= J_OUT + J_FFI; Wsrc = w_ffo; Wdst = (bf16*)(ws + WS_WFFO); Nn = DM; ldk = FF; }
                        else if (r >= J_OUT) { r -= J_OUT; Wsrc = w_ffi; Wdst = (bf16*)(ws + WS_WFFI); Nn = 2 * FF; ldk = DM; pm = true; }
                        const int nblk = Nn >> 6, kb = r / nblk, n = 64 * (r % nblk) + lane, k0 = 8 * kb; const float* sp = Wsrc + (size_t)k0 * Nn + n;
                        u32x4 o; o.x = pk2(sp[0], sp[(size_t)Nn]); o.y = pk2(sp[(size_t)2 * Nn], sp[(size_t)3 * Nn]); o.z = pk2(sp[(size_t)4 * Nn], sp[(size_t)5 * Nn]); o.w = pk2(sp[(size_t)6 * Nn], sp[(size_t)7 * Nn]);
                        const int drow = pm ? (n < FF ? 8 * (n >> 2) + (n & 3) : 8 * ((n - FF) >> 2) + 4 + ((n - FF) & 3)) : n;
                        *(u32x4*)(Wdst + (size_t)drow * ldk + k0) = o; }
                }
                __syncthreads();
            }
            { const int hc = NHC; const int jj = t >> 3, q0 = 4 * (t & 7); const int R = rw_hrow(b, dir, hc - 1, jj); const LAS float* yb = ybufb + ((hc - 1) & 1) * 1024 + jj * 32 + q0;
              u32x2 w; w.x = pk2(yb[0], yb[1]); w.y = pk2(yb[2], yb[3]); *(u32x2*)(Y + ((size_t)dir * ML + R) * 512 + h * 64 + 32 * half + q0) = w; }
        } else {
            const int rr = lane >> 3, c = lane & 7, c8 = 8 * c, rowl = 8 * wave + rr, row = 32 * half + rowl;
            f32x2 S[4];
#pragma unroll
            for (int q = 0; q < 4; ++q) S[q] = (f32x2){0.f, 0.f};
            __syncthreads();
#pragma unroll 1
            for (int hc = 0; hc < NHC; ++hc) {
                const LAS float* fb = featb + (hc & 1) * 12288; LAS float* yb = ybufb + (hc & 1) * 1024;
                RwFeat f0 = rw_ldfeat(fb, c8, row);
#pragma unroll 1
                for (int j0 = 0; j0 < 32; j0 += 8) {
                    float ykeep = 0.f;
#pragma unroll
                    for (int u = 0; u < 8; ++u) {
                        const int jn = (j0 + u + 1) < 32 ? (j0 + u + 1) : 31;
                        const RwFeat f2 = rw_ldfeat(fb + jn * 384, c8, row);
                        __builtin_amdgcn_sched_barrier(0);
                        const float y = rw_step(S, f0);
                        ykeep = (c == u) ? y : ykeep;
                        f0 = f2;
                    }
                    yb[(j0 + c) * 32 + rowl] = ykeep;
                    { f32x2 rho[4]; RW_LD2(rho, fb + (j0 + 7) * 384, 64)
#pragma unroll
                      for (int q = 0; q < 4; ++q) S[q] = S[q] * rho[q]; }
                }
                __syncthreads();
            }
        }
        __syncthreads();
    }
}
__device__ __forceinline__ void rwkv_assemble(const bf16* P, const bf16* WAG, const bf16* Y, const float* mu, const float* kaw, const float* rkw, const float* lnw, const float* lnb, bf16* Mx, int lane, int gw, int NGW) {
    for (int R = gw; R < ML; R += NGW) {
        const int c = 8 * lane; const Nb4 nb = neighbors(R);
        float r[8], k[8], v[8], a0[8], a1[8], g[8];
        { const Raw5 x = load_raw5(P, R, nb, c); xm8(x, mu + c, r); }
        { const Raw5 x = load_raw5(P, R, nb, PC_K + c); xm8(x, mu + PC_K + c, k); }
        { const Raw5 x = load_raw5(P, R, nb, PC_V + c); xm8(x, mu + PC_V + c, v); }
        unpack8(*(const u32x4*)(WAG + (size_t)R * NLO + 1024 + c), a0); unpack8(*(const u32x4*)(WAG + (size_t)R * NLO + 1536 + c), a1); unpack8(*(const u32x4*)(WAG + (size_t)R * NLO + 2048 + c), g);
        float y[8], yb[8]; unpack8(*(const u32x4*)(Y + (size_t)R * 512 + c), y); unpack8(*(const u32x4*)(Y + ((size_t)ML + R) * 512 + c), yb);
#pragma unroll
        for (int q = 0; q < 8; ++q) y[q] += yb[q];
        float s = 0.f;
#pragma unroll
        for (int q = 0; q < 8; ++q) s += y[q];
        const float mean = red8(s) * (1.f / 64.f); float sq = 0.f, bs = 0.f;
#pragma unroll
        for (int q = 0; q < 8; ++q) { const float d = y[q] - mean; sq += d * d; bs += r[q] * (k[q] * (2.0f + (a0[q] + a1[q] - 2.0f) * kaw[c + q])) * rkw[c + q]; }
        const float rstd = rsqrtf(red8(sq) * (1.f / 64.f) + 64e-5f); bs = red8(bs);
        float o[8];
#pragma unroll
        for (int q = 0; q < 8; ++q) o[q] = ((y[q] - mean) * rstd * lnw[c + q] + lnb[c + q] + bs * v[q]) * g[q];
        *(u32x4*)(Mx + (size_t)R * DM + c) = pack8(o);
    }
}
#define XB_TMO      128
#define XB_XCNT(j)  (256  + 64 * (j))
#define XB_XSUB(j)  (1280 + 64 * (j))
#define XB_XGEN(j)  (2304 + 64 * (j))
#define XB_TOP      3328
#define XB_TOPGEN   3392
#define XCD_BAR_WORDS 3456
#define XB_SPIN_CAP (1u << 18)

__device__ __forceinline__ unsigned xb_ld(unsigned* p)              { return __hip_atomic_load(p, __ATOMIC_RELAXED, __HIP_MEMORY_SCOPE_AGENT); }
__device__ __forceinline__ unsigned xb_add(unsigned* p, unsigned v) { return __hip_atomic_fetch_add(p, v, __ATOMIC_RELAXED, __HIP_MEMORY_SCOPE_AGENT); }
__device__ __forceinline__ unsigned xb_xcc_id() { return (unsigned)__builtin_amdgcn_s_getreg((3 << 11) | 20) & 0xFu; }
#define XB_SPIN(cond, bar) do { unsigned _sp = 0; while (cond) { __builtin_amdgcn_s_sleep(1); \
    if ((++_sp & 255u) == 0u) { if (xb_ld(&(bar)[XB_TMO])) break; if (_sp > XB_SPIN_CAP) { atomicAdd(&(bar)[XB_TMO], 1u); break; } } } } while (0)

struct XcdBarrier {
    unsigned* bar; unsigned x;
    volatile LAS unsigned* st;
};

__device__ __forceinline__ XcdBarrier xcd_barrier_post(unsigned* bar, volatile LAS unsigned* st) {
    XcdBarrier b; b.bar = bar; b.x = xb_xcc_id(); b.st = st;
    if (threadIdx.x == 0) (void)xb_add(&bar[XB_XCNT(b.x)], 1u);
    return b;
}
__device__ __forceinline__ void xcd_barrier_complete(unsigned* bar, unsigned x, unsigned& nloc, unsigned& nx) {
    const unsigned G = gridDim.x * gridDim.y * gridDim.z;
    unsigned sum, cnt, mine, sp = 0u;
    for (;;) {
        sum = 0u; cnt = 0u; mine = 0u;
#pragma unroll
        for (unsigned j = 0; j < 16; ++j) { const unsigned c = xb_ld(&bar[XB_XCNT(j)]); sum += c; cnt += (c > 0u) ? 1u : 0u; mine = (j == x) ? c : mine; }
        if (sum == G) break;
        __builtin_amdgcn_s_sleep(1);
        if ((++sp & 255u) == 0u) { if (xb_ld(&bar[XB_TMO])) break; if (sp > XB_SPIN_CAP) { atomicAdd(&bar[XB_TMO], 1u); break; } }
    }
    nloc = mine > 0u ? mine : 1u; nx = cnt > 0u ? cnt : 1u;
}

__device__ __forceinline__ void xcd_barrier(const XcdBarrier& b) {
    asm volatile("s_waitcnt vmcnt(0)" ::: "memory");
    __syncthreads();
    if (threadIdx.x == 0) {
        unsigned* bar = b.bar;
        __builtin_amdgcn_s_waitcnt(0);
        unsigned nloc = b.st[0], nx = b.st[1];
        if (nloc == 0u) { xcd_barrier_complete(bar, b.x, nloc, nx); b.st[0] = nloc; b.st[1] = nx; }
        const unsigned old = xb_add(&bar[XB_XSUB(b.x)], 1u);
        const unsigned gen = old / nloc;
        if (old + 1u == (gen + 1u) * nloc) {
            __builtin_amdgcn_fence(__ATOMIC_RELEASE, "agent");
            asm volatile("s_waitcnt vmcnt(0)" ::: "memory");
            const unsigned og = xb_add(&bar[XB_TOP], 1u);
            const unsigned tg = og / nx;
            if (og + 1u == (tg + 1u) * nx) xb_add(&bar[XB_TOPGEN], 1u);
            else XB_SPIN(xb_ld(&bar[XB_TOPGEN]) == tg, bar);
            __builtin_amdgcn_fence(__ATOMIC_ACQUIRE, "agent");
            xb_add(&bar[XB_XGEN(b.x)], 1u);
            asm volatile("s_waitcnt vmcnt(0)" ::: "memory");
        } else {
            XB_SPIN(xb_ld(&bar[XB_XGEN(b.x)]) == gen, bar);
            __builtin_amdgcn_fence(__ATOMIC_ACQUIRE, "agent");
            asm volatile("s_waitcnt vmcnt(0)" ::: "memory");
        }
    }
    __syncthreads();
}

__global__ void __launch_bounds__(512, 2) mega_fwd(Args a) {
    extern __shared__ __attribute__((aligned(16))) unsigned char lds_raw[];
    LAS unsigned char* lds = (LAS unsigned char*)lds_raw;
    cg::grid_group grid = cg::this_grid();
#define GSYNC() do { asm volatile("s_waitcnt vmcnt(0)" ::: "memory"); grid.sync(); } while (0)
    volatile LAS unsigned* bst = (volatile LAS unsigned*)(lds + LDS_BYTES - 64);
    if (threadIdx.x < 2) bst[threadIdx.x] = 0u;
    __syncthreads();
    const XcdBarrier xbar = xcd_barrier_post((unsigned*)a.ws, bst);
#define XSYNC() xcd_barrier(xbar)
    const int tid = threadIdx.x, lane = tid & 63, wave = __builtin_amdgcn_readfirstlane(tid >> 6);
    const int G = gridDim.x, bx = blockIdx.x, gw = bx * 8 + wave, NGW = G * 8;
    unsigned char* ws = a.ws;
    bf16* P = (bf16*)(ws + WS_P); bf16* XN = (bf16*)(ws + WS_XN); bf16* WAG = (bf16*)(ws + WS_WAG); bf16* GS = (bf16*)(ws + WS_GS); float* GAM = (float*)(ws + WS_GAM);
    float* mod = (float*)(ws + WS_MOD); bf16* Y = (bf16*)a.out; bf16* LA = (bf16*)((unsigned char*)a.out + 64 * MiB); bf16* Mx = LA;
    bf16* H = (bf16*)(ws + WS_H); bf16* H2 = (bf16*)(ws + WS_H2);   bf16* XN2 = (bf16*)(ws + WS_XN2); bf16* HMID = (bf16*)(ws + WS_HMID);
    const float* mu = a.in[8];

    phase0(a, lds, tid, lane, wave);
    if (a.ws == nullptr) GSYNC();
    XSYNC();
#if defined(STOP_AFTER)
    if (STOP_AFTER == 1) return;
#endif
    for (int R = gw; R < MT; R += 2 * NGW) {
        const int R2 = R + NGW; const bool two = R2 < MT;
        const float* src = R < ML ? a.in[0] + (size_t)R * DM : a.in[2] + (size_t)(R - ML) * DM; const float* mrow = mod + (size_t)(R < ML ? (R >> 12) : 8) * MODN;
        const NormRow r0 = norm_load(src, lane);
        if (two) { const float* src2 = R2 < ML ? a.in[0] + (size_t)R2 * DM : a.in[2] + (size_t)(R2 - ML) * DM; const float* mrow2 = mod + (size_t)(R2 < ML ? (R2 >> 12) : 8) * MODN;
            const NormRow r1 = norm_load(src2, lane);
            norm_finish<0>(r0, a.in[6], mrow, mrow + 1024, XN + (size_t)R * DM, lane);
            norm_finish<0>(r1, a.in[6], mrow2, mrow2 + 1024, XN + (size_t)R2 * DM, lane); }
        else norm_finish<0>(r0, a.in[6], mrow, mrow + 1024, XN + (size_t)R * DM, lane);
    }
    XSYNC();
#if defined(STOP_AFTER)
    if (STOP_AFTER == 2) return;
#endif
    { pg8::Gemm g{XN, (const bf16*)(ws + WS_WIN), MT, NINP, DM}; asm volatile("" : "+s"(g.K)); pg8::StaticOrder S; S.init(MT, NINP, G, bx);
      pg8::EpiBf16<0> E{P, NINP, nullptr, 0, 0, 1.f};
      pg8::gemm_phase<pg8::EpiBf16<0>, pg8::StaticOrder, true, true>(lds, g, S, E); }
    XSYNC();
#if defined(STOP_AFTER)
    if (STOP_AFTER == 3) return;
#endif
    phase_la(P, mu, LA, lane, gw, NGW);
    gla_pass_a(P, a.in[19], a.in[20], GS, GAM, lds, tid, lane, wave);
    XSYNC();
#if defined(STOP_AFTER)
    if (STOP_AFTER == 4) return;
#endif
    if (G != 256) gla_pass_b(GS, GAM, tid);
    { pg8::Gemm g{LA, (const bf16*)(ws + WS_WLORA), MT, NLO, KLB, KLO, 128, 256}; asm volatile("" : "+s"(g.K)); pg8::StaticOrder S; S.init(MT, NLO, G, bx);
      pg8::EpiLora E{WAG, NLO, a.in[9], a.in[11]};
      pg8::gemm_phase<pg8::EpiLora, pg8::StaticOrder, true, true>(lds, g, S, E); }
    XSYNC();
#if defined(STOP_AFTER)
    if (STOP_AFTER == 5) return;
#endif
    rwkv_scan(P, WAG, mu, a.in[14], a.in[15], Y, lds, tid, lane, wave, GS, GAM, a.in[22], a.in[24], a.in[25], ws);
    XSYNC();
#if defined(STOP_AFTER)
    if (STOP_AFTER == 6) return;
#endif
    { const AsmCtx AC{P, WAG, Y, mu, a.in[15], a.in[16], a.in[17], a.in[18], Mx};
      gla_pass_c(P, a.in[19], a.in[20], a.in[21], GS, Mx, lds, tid, lane, wave, AC, gw, NGW); }
    XSYNC();
#if defined(STOP_AFTER)
    if (STOP_AFTER == 7) return;
#endif
    { pg8::Gemm g{Mx, (const bf16*)(ws + WS_WOUT), ML, DM, DM}; asm volatile("" : "+s"(g.K)); pg8::StaticOrder S; S.init(ML, DM, G, bx);
      pg8::EpiGateRes<false, true> E{a.in[0], mod + 2048, H, DM, MODN};
      pg8::gemm_phase<pg8::EpiGateRes<false, true>, pg8::StaticOrder, true, true>(lds, g, S, E); }
    XSYNC();
#if defined(STOP_AFTER)
    if (STOP_AFTER == 8) return;
#endif
    for (int R = gw; R < ML; R += 2 * NGW) { const int R2r = R + NGW; const bool two8 = R2r < ML; const int R2 = two8 ? R2r : R;
        const float* mrow = mod + (size_t)(R >> 12) * MODN; const float* mrow2 = mod + (size_t)(R2 >> 12) * MODN;
        const NormRowB r0 = normb_load(H + (size_t)R * DM, lane), r1 = normb_load(H + (size_t)R2 * DM, lane);
        normb_finish(r0, a.in[23], mrow + 3072, mrow + 4096, XN2 + (size_t)R * DM, lane);
        if (two8) normb_finish(r1, a.in[23], mrow2 + 3072, mrow2 + 4096, XN2 + (size_t)R2 * DM, lane); }
    XSYNC();
#if defined(STOP_AFTER)
    if (STOP_AFTER == 9) return;
#endif
    { pg8::Gemm g{XN2, (const bf16*)(ws + WS_WFFI), ML, 2 * FF, DM}; asm volatile("" : "+s"(g.K)); pg8::StaticOrder S; S.init(ML, 2 * FF, G, bx);
      pg8::EpiSwiglu E{HMID, FF};
      pg8::gemm_phase<pg8::EpiSwiglu, pg8::StaticOrder, true, true>(lds, g, S, E); }
    XSYNC();
#if defined(STOP_AFTER)
    if (STOP_AFTER == 10) return;
#endif
    { pg8::Gemm g{HMID, (const bf16*)(ws + WS_WFFO), ML, DM, FF}; asm volatile("" : "+s"(g.K)); pg8::StaticOrder S; S.init(ML, DM, G, bx);
      pg8::EpiGateRes<true, true> E{H, mod + 5120, H2, DM, MODN};
      pg8::gemm_phase<pg8::EpiGateRes<true, true>, pg8::StaticOrder, true, true>(lds, g, S, E); }
    XSYNC();
#if defined(STOP_AFTER)
    if (STOP_AFTER == 11) return;
#endif
    for (int R = gw; R < ML; R += 2 * NGW) { const int R2r = R + NGW; const bool two11 = R2r < ML; const int R2 = two11 ? R2r : R;
        const NormRowB r0 = normb_load(H2 + (size_t)R * DM, lane), r1 = normb_load(H2 + (size_t)R2 * DM, lane);
        normb_final(r0, a.in[26], a.out + (size_t)R * DM, lane);
        if (two11) normb_final(r1, a.in[26], a.out + (size_t)R2 * DM, lane); }
}

extern "C" void kernel_launch(void* const* d_in, const int* in_sizes, int n_in, void* d_out, int out_size, void* d_ws, size_t ws_size, hipStream_t stream) {
    static int grid = 0;
    if (grid == 0) {
        if (n_in != 27 || out_size != ML * DM || ws_size < WS_END) { fprintf(stderr, "kernel_launch: unexpected shapes (n_in %d out %d ws %zu)\n", n_in, out_size, ws_size); grid = -1; return; }
        int dev = 0, cus = 0, per_cu = 0;
        hipGetDevice(&dev); hipDeviceGetAttribute(&cus, hipDeviceAttributeMultiprocessorCount, dev);
        if (hipFuncSetAttribute((const void*)mega_fwd, hipFuncAttributeMaxDynamicSharedMemorySize, LDS_BYTES) != hipSuccess) { fprintf(stderr, "kernel_launch: hipFuncSetAttribute failed\n"); grid = -1; return; }
        hipOccupancyMaxActiveBlocksPerMultiprocessor(&per_cu, (const void*)mega_fwd, 512, LDS_BYTES);
        (void)hipGetLastError();
        if (per_cu < 1) { fprintf(stderr, "kernel_launch: occupancy query says %d blocks per CU\n", per_cu); per_cu = 1; }
        grid = cus;
    }
    if (grid < 0) return;
    if (hipMemsetAsync(d_ws, 0, 16384, stream) != hipSuccess) { fprintf(stderr, "kernel_launch: memset failed\n"); return; }
    Args a{};
    for (int i = 0; i < 27; ++i) a.in[i] = (const float*)d_in[i];
    a.out = (float*)d_out; a.ws = (unsigned char*)d_ws;
    void* args[] = {&a};
    hipError_t e = hipLaunchCooperativeKernel((const void*)mega_fwd, dim3(grid), dim3(512), args, LDS_BYTES, stream);
    if (e != hipSuccess) fprintf(stderr, "cooperative launch failed: %s (grid %d)\n", hipGetErrorString(e), grid);
}
```

```cpp
#include <hip/hip_runtime.h>
#include <hip/hip_cooperative_groups.h>
#include <cstdio>
#include <cstdint>
namespace cg = cooperative_groups;
namespace pg8 {
#define PG8_LAS __attribute__((address_space(3)))
typedef unsigned short bf16_t;
typedef short bf16x8 __attribute__((ext_vector_type(8)));
typedef float f32x4 __attribute__((ext_vector_type(4)));
typedef unsigned u32x4 __attribute__((ext_vector_type(4)));
constexpr int BM = 256, BK = 64, HALF = 128, HTB = HALF * BK * 2  , STAGE_BYTES = 8 * HTB, NXCD = 8, WGM = 8;

__host__ __device__ __forceinline__ int lds_byte(int r, int c) { const int st = (r >> 4) * 2 + (c >> 5), rr = r & 15, cc = c & 31, ob = rr * 64 + cc * 2; return st * 1024 + (ob ^ (((ob >> 9) & 1) << 5)); }
__host__ __device__ __forceinline__ void stage_rc(int b, int& R, int& C) { const int st = b / 1024, sb = b % 1024, swz = sb ^ (((sb >> 9) & 1) << 5); R = (st >> 1) * 16 + swz / 64; C = (st & 1) * 32 + (swz % 64) / 2; }
__host__ __device__ __forceinline__ int perm32(int rho) { const int n = rho >> 4, i = rho & 15; return 8 * (i >> 2) + 4 * n + (i & 3); }

struct Unit { int pm, pn; };
struct Gemm { const bf16_t* A; const bf16_t* Bt; int M, N, K; int lda, acol4, acol8; };

struct StaticOrder {
    int nM, nN, nwg, G, c;
    __host__ __device__ void init(int M, int N, int G_, int c_) { nM = M / BM; nN = N / BM; nwg = nM * nN; G = G_; c = c_; }
    __host__ __device__ bool next(int i, Unit& u) const {
        const long L = (long)i * G + c; if (L >= nwg) return false;
        int wgid = (int)L; { const int q = nwg / NXCD, r = nwg % NXCD, xcd = wgid % NXCD, off = wgid / NXCD; wgid = (xcd < r ? xcd * (q + 1) : r * (q + 1) + (xcd - r) * q) + off; }
        const int nig = WGM * nN, gid = wgid / nig, fm = gid * WGM, gsz = (nM - fm) < WGM ? (nM - fm) : WGM;
        u.pm = fm + ((wgid % nig) % gsz); u.pn = (wgid % nig) / gsz; return true;
    }
    __device__ __forceinline__ void a_ready(const Unit&) const {}
    __device__ __forceinline__ void done(const Unit&) const {}
};

typedef __bf16 bf16v2_t __attribute__((ext_vector_type(2)));
typedef float f32v2_t __attribute__((ext_vector_type(2)));
__device__ __forceinline__ unsigned cvt_pk_bf16(float lo, float hi) { const f32v2_t v = {lo, hi}; const bf16v2_t b = __builtin_convertvector(v, bf16v2_t); return __builtin_bit_cast(unsigned, b); }
typedef float f32x2 __attribute__((ext_vector_type(2)));
__device__ __forceinline__ f32x2 gelu_pk(f32x2 v) {
    const f32x2 av = __builtin_elementwise_abs(v), d = av * 0.2316418882f + 1.0f;
    f32x2 t; t.x = __builtin_amdgcn_rcpf(d.x); t.y = __builtin_amdgcn_rcpf(d.y);
    f32x2 q = t * 0.5307027145f + (-0.7265760135f); q = q * t + 0.7107068705f; q = q * t + (-0.142248368f); q = q * t + 0.127414796f; q = q * t;
    const f32x2 s = (v * v) * (-0.72134752044f);
    f32x2 e; e.x = __builtin_amdgcn_exp2f(s.x); e.y = __builtin_amdgcn_exp2f(s.y);
    const f32x2 m = v * (q * e), r = v - m;
    f32x2 o; o.x = v.x < 0.f ? m.x : r.x; o.y = v.y < 0.f ? m.y : r.y; return o;
}

template <int ACT  > struct EpiBf16 {
    static constexpr bool PERM = true, AFTER_DRAIN = false; static_assert(ACT == 0 || ACT == 1, "EpiBf16: ACT is 0 (none) or 1 (gelu_pk)");
    bf16_t* O; int ldc; const float* bias; int split_cols; size_t split_stride; float scale0;
    __device__ __forceinline__ void operator()(const f32x4 (&acc)[2][2][4][2], const Unit& u, int wr, int wc, int fr, int fq) const {
        const int row0 = u.pm * BM + wr * 64 + fr; int colt = u.pn * BM; bf16_t* base = O;
        float sc = 1.f; if (split_cols) { const int t = colt / split_cols; base += (size_t)t * split_stride; colt -= t * split_cols; if (t == 0) sc = scale0; }
        const int col0 = colt + wc * 32 + 8 * fq, bcol0 = u.pn * BM + wc * 32 + 8 * fq;
        f32x4 bv[2][2];
#pragma unroll
        for (int bj = 0; bj < 2; ++bj)
#pragma unroll
            for (int n = 0; n < 2; ++n) bv[bj][n] = bias ? *(const f32x4*)(bias + bcol0 + bj * HALF + 4 * n) : (f32x4){0.f, 0.f, 0.f, 0.f};
#pragma unroll
        for (int ai = 0; ai < 2; ++ai)
#pragma unroll
            for (int m = 0; m < 4; ++m) { bf16_t* rowp = base + (size_t)(row0 + ai * HALF + m * 16) * ldc + col0;
#pragma unroll
                for (int bj = 0; bj < 2; ++bj) { f32x4 v0 = acc[ai][bj][m][0] + bv[bj][0], v1 = acc[ai][bj][m][1] + bv[bj][1];
                    if (ACT == 1) { f32x2 a = gelu_pk((f32x2){v0[0], v0[1]}), b = gelu_pk((f32x2){v0[2], v0[3]}), c = gelu_pk((f32x2){v1[0], v1[1]}), d = gelu_pk((f32x2){v1[2], v1[3]});
                        v0 = (f32x4){a.x, a.y, b.x, b.y}; v1 = (f32x4){c.x, c.y, d.x, d.y}; }
                    v0 = v0 * sc; v1 = v1 * sc; u32x4 w; w.x = cvt_pk_bf16(v0[0], v0[1]); w.y = cvt_pk_bf16(v0[2], v0[3]); w.z = cvt_pk_bf16(v1[0], v1[1]); w.w = cvt_pk_bf16(v1[2], v1[3]);
                    *(u32x4*)(rowp + bj * HALF) = w; } }
    }
};
__device__ __forceinline__ float sigmoidf_(float v) { return __builtin_amdgcn_rcpf(1.0f + __expf(-v)); }
struct EpiLora {
    static constexpr bool PERM = true, AFTER_DRAIN = false;
    bf16_t* O; int ldc; const float* w0; const float* a0;
    __device__ __forceinline__ void operator()(const f32x4 (&acc)[2][2][4][2], const Unit& u, int wr, int wc, int fr, int fq) const {
        const int row0 = u.pm * BM + wr * 64 + fr; const int col0 = u.pn * BM + wc * 32 + 8 * fq;
        if (u.pn < 8) {
            const float sc = u.pn < 4 ? 0.60653065971f : 1.0f;
            const float* bp = u.pn < 4 ? (w0 + col0) : (a0 + (col0 - 1024));
#pragma unroll
            for (int bj = 0; bj < 2; ++bj) { const f32x4 b0 = *(const f32x4*)(bp + bj * HALF), b1 = *(const f32x4*)(bp + bj * HALF + 4);
#pragma unroll
                for (int ai = 0; ai < 2; ++ai)
#pragma unroll
                    for (int m = 0; m < 4; ++m) { f32x4 v0 = acc[ai][bj][m][0] + b0, v1 = acc[ai][bj][m][1] + b1;
#pragma unroll
                        for (int e = 0; e < 4; ++e) { v0[e] = sigmoidf_(v0[e]) * sc; v1[e] = sigmoidf_(v1[e]) * sc; }
                        u32x4 w; w.x = cvt_pk_bf16(v0[0], v0[1]); w.y = cvt_pk_bf16(v0[2], v0[3]); w.z = cvt_pk_bf16(v1[0], v1[1]); w.w = cvt_pk_bf16(v1[2], v1[3]);
                        *(u32x4*)(O + (size_t)(row0 + ai * HALF + m * 16) * ldc + col0 + bj * HALF) = w; } }
        } else {
#pragma unroll
            for (int bj = 0; bj < 2; ++bj)
#pragma unroll
                for (int ai = 0; ai < 2; ++ai)
#pragma unroll
                    for (int m = 0; m < 4; ++m) { const f32x4 v0 = acc[ai][bj][m][0], v1 = acc[ai][bj][m][1];
                        u32x4 w; w.x = cvt_pk_bf16(v0[0], v0[1]); w.y = cvt_pk_bf16(v0[2], v0[3]); w.z = cvt_pk_bf16(v1[0], v1[1]); w.w = cvt_pk_bf16(v1[2], v1[3]);
                        *(u32x4*)(O + (size_t)(row0 + ai * HALF + m * 16) * ldc + col0 + bj * HALF) = w; }
        }
    }
};
template <bool BF16_BASE, bool BF16_OUT> struct EpiGateRes {
    static constexpr bool PERM = true, AFTER_DRAIN = false;
    const void* base; const float* gate; void* out; int ldc; int gstride;
    __device__ __forceinline__ void operator()(const f32x4 (&acc)[2][2][4][2], const Unit& u, int wr, int wc, int fr, int fq) const {
        const int col0 = u.pn * BM + wc * 32 + 8 * fq;
        const float* gp = gate + (size_t)((u.pm * BM) >> 12) * gstride + col0;
        f32x4 gv[2][2];
#pragma unroll
        for (int bj = 0; bj < 2; ++bj)
#pragma unroll
            for (int n = 0; n < 2; ++n) gv[bj][n] = *(const f32x4*)(gp + bj * HALF + 4 * n);
#pragma unroll
        for (int ai = 0; ai < 2; ++ai)
#pragma unroll
            for (int m = 0; m < 4; ++m) { const size_t off = (size_t)(u.pm * BM + ai * HALF + wr * 64 + m * 16 + fr) * ldc + col0;
#pragma unroll
                for (int bj = 0; bj < 2; ++bj) { f32x4 b0, b1;
                    if (BF16_BASE) { const u32x4 w = *(const u32x4*)((const bf16_t*)base + off + bj * HALF);
                        b0 = (f32x4){__uint_as_float(w.x << 16), __uint_as_float(w.x & 0xffff0000u), __uint_as_float(w.y << 16), __uint_as_float(w.y & 0xffff0000u)};
                        b1 = (f32x4){__uint_as_float(w.z << 16), __uint_as_float(w.z & 0xffff0000u), __uint_as_float(w.w << 16), __uint_as_float(w.w & 0xffff0000u)}; }
                    else { b0 = *(const f32x4*)((const float*)base + off + bj * HALF); b1 = *(const f32x4*)((const float*)base + off + bj * HALF + 4); }
                    const f32x4 o0 = b0 + gv[bj][0] * acc[ai][bj][m][0], o1 = b1 + gv[bj][1] * acc[ai][bj][m][1];
                    if (BF16_OUT) { u32x4 w; w.x = cvt_pk_bf16(o0[0], o0[1]); w.y = cvt_pk_bf16(o0[2], o0[3]); w.z = cvt_pk_bf16(o1[0], o1[1]); w.w = cvt_pk_bf16(o1[2], o1[3]);
                        *(u32x4*)((bf16_t*)out + off + bj * HALF) = w; }
                    else { *(f32x4*)((float*)out + off + bj * HALF) = o0; *(f32x4*)((float*)out + off + bj * HALF + 4) = o1; } } }
    }
};
struct EpiSwiglu {
    static constexpr bool PERM = true, AFTER_DRAIN = false;
    bf16_t* O; int ldo;
    __device__ __forceinline__ void operator()(const f32x4 (&acc)[2][2][4][2], const Unit& u, int wr, int wc, int fr, int fq) const {
        const int row0 = u.pm * BM + wr * 64 + fr; const int h0 = (u.pn * BM + wc * 32 + 8 * fq) >> 1;
        typedef unsigned u32x2v __attribute__((ext_vector_type(2)));
#pragma unroll
        for (int ai = 0; ai < 2; ++ai)
#pragma unroll
            for (int m = 0; m < 4; ++m) { bf16_t* rowp = O + (size_t)(row0 + ai * HALF + m * 16) * ldo + h0;
#pragma unroll
                for (int bj = 0; bj < 2; ++bj) { const f32x4 g = acc[ai][bj][m][0], up = acc[ai][bj][m][1]; f32x4 h;
#pragma unroll
                    for (int e = 0; e < 4; ++e) h[e] = g[e] * sigmoidf_(g[e]) * up[e];
                    u32x2v w; w.x = cvt_pk_bf16(h[0], h[1]); w.y = cvt_pk_bf16(h[2], h[3]);
                    *(u32x2v*)(rowp + bj * (HALF / 2)) = w; } }
    }
};
template <class Epi, class Sched, bool ALIGN_EPI = false, bool SP2 = false>
__device__ __forceinline__ void gemm_phase(PG8_LAS unsigned char* lds, const Gemm g, const Sched& S, const Epi& E) {
    const int tid = threadIdx.x, wid = __builtin_amdgcn_readfirstlane(tid >> 6), lane = tid & 63, wr = wid >> 2, wc = wid & 3, fr = lane & 15, fq = lane >> 4;
    const int K = g.K, nt = K / BK;
    const int lda = g.lda ? g.lda : K;
    unsigned voffA[2], voffB[2];
#pragma unroll
    for (int i = 0; i < 2; ++i) { int R, C; stage_rc(tid * 16 + i * 8192, R, C); const int Rb = Epi::PERM ? ((R & ~31) + perm32(R & 31)) : R;
        voffA[i] = (unsigned)(R * lda + C) * 2u; voffB[i] = (unsigned)(Rb * K + C) * 2u; }
    const size_t kstep = (size_t)(BK * 2);
    const size_t hstep = (size_t)HALF * K * 2;
    const size_t tstep = 2 * hstep;
    const size_t hstepA = (size_t)HALF * lda * 2, tstepA = 2 * hstepA;
#define PG8_ACOL(pn) ((size_t)((pn) < 4 ? 0 : ((pn) < 8 ? g.acol4 : g.acol8)) * 2)
    const unsigned ldsw = (unsigned)wid * 1024u;
    const int aoff = lds_byte(wr * 64 + fr, fq * 8), boff = lds_byte(wc * 32 + fr, fq * 8);
#define PG8_SA(b, h) (((b) * 2 + (h)) * HTB)
#define PG8_SB(b, h) ((4 + (b) * 2 + (h)) * HTB)
#define PG8_STAGE(bufoff, gbase, voff) do { _Pragma("unroll") for (int _i = 0; _i < 2; ++_i) \
        __builtin_amdgcn_global_load_lds((const unsigned*)((const char*)(gbase) + (voff)[_i]), (PG8_LAS unsigned*)(lds + (bufoff) + ldsw + _i * 8192), 16, 0, 0); } while (0)
#define PG8_LDA(dst, b, h) do { _Pragma("unroll") for (int m = 0; m < 4; ++m) _Pragma("unroll") for (int k = 0; k < 2; ++k) dst[m][k] = *(const PG8_LAS bf16x8*)(lds + PG8_SA(b, h) + aoff + m * 2048 + k * 1024); } while (0)
#define PG8_LDB(dst, b, h) do { _Pragma("unroll") for (int n = 0; n < 2; ++n) _Pragma("unroll") for (int k = 0; k < 2; ++k) dst[n][k] = *(const PG8_LAS bf16x8*)(lds + PG8_SB(b, h) + boff + n * 2048 + k * 1024); } while (0)
#define PG8_MMA(ai, bj, At, Bt) do { __builtin_amdgcn_s_setprio(1); _Pragma("unroll") for (int m = 0; m < 4; ++m) _Pragma("unroll") for (int n = 0; n < 2; ++n) _Pragma("unroll") for (int k = 0; k < 2; ++k) \
        acc[ai][bj][m][n] = __builtin_amdgcn_mfma_f32_16x16x32_bf16(Bt[n][k], At[m][k], acc[ai][bj][m][n], 0, 0, 0); __builtin_amdgcn_s_setprio(0); } while (0)
#define PG8_WAIT_V(n) asm volatile("s_waitcnt vmcnt(" #n ")" ::: "memory")
#define PG8_WAIT_L(n) asm volatile("s_waitcnt lgkmcnt(" #n ")" ::: "memory")
#define PG8_BAR __builtin_amdgcn_s_barrier()
#define PG8_SCHED __builtin_amdgcn_sched_barrier(0)
    Unit cur, nxt; int ui = 0;
    if (!S.next(0, cur)) return;
    f32x4 acc[2][2][4][2];
#pragma unroll
    for (int a = 0; a < 2; ++a)
#pragma unroll
        for (int b = 0; b < 2; ++b)
#pragma unroll
            for (int m = 0; m < 4; ++m)
#pragma unroll
                for (int n = 0; n < 2; ++n) acc[a][b][m][n] = (f32x4){0.f, 0.f, 0.f, 0.f};
    bf16x8 At[4][2], B0[2][2], B1[2][2];
    const char* cA = (const char*)g.A + (size_t)cur.pm * tstepA + PG8_ACOL(cur.pn); const char* cB = (const char*)g.Bt + (size_t)cur.pn * tstep;
    S.a_ready(cur);
    if constexpr (SP2) {
        PG8_STAGE(PG8_SB(0, 0), cB, voffB); PG8_STAGE(PG8_SB(0, 1), cB + hstep, voffB); PG8_STAGE(PG8_SA(0, 0), cA, voffA); PG8_STAGE(PG8_SA(0, 1), cA + hstepA, voffA);
        if (wr == 1) PG8_BAR;
        PG8_WAIT_V(2); PG8_BAR;
        PG8_STAGE(PG8_SB(1, 0), cB + kstep, voffB); PG8_STAGE(PG8_SA(1, 0), cA + kstep, voffA); PG8_STAGE(PG8_SB(1, 1), cB + hstep + kstep, voffB);
        PG8_WAIT_V(6); PG8_BAR;
    } else {
        PG8_STAGE(PG8_SB(0, 0), cB, voffB); PG8_STAGE(PG8_SA(0, 0), cA, voffA); PG8_STAGE(PG8_SB(0, 1), cB + hstep, voffB); PG8_STAGE(PG8_SA(0, 1), cA + hstepA, voffA);
        if (wr == 1) PG8_BAR;
        PG8_WAIT_V(4); PG8_BAR;
        PG8_STAGE(PG8_SB(1, 0), cB + kstep, voffB); PG8_STAGE(PG8_SA(1, 0), cA + kstep, voffA); PG8_STAGE(PG8_SB(1, 1), cB + hstep + kstep, voffB);
        PG8_WAIT_V(6); PG8_BAR;
    }
    for (;;) {
        const bool has_next = S.next(ui + 1, nxt);
        const char* nA = has_next ? (const char*)g.A + (size_t)nxt.pm * tstepA + PG8_ACOL(nxt.pn) : cA; const char* nB = has_next ? (const char*)g.Bt + (size_t)nxt.pn * tstep : cB;
        for (int t = 0; t < nt; t += 2) {
            const bool last = (t == nt - 2);
            const char* a1 = cA + (size_t)(t + 1) * kstep;
            const char* a2 = last ? nA : cA + (size_t)(t + 2) * kstep; const char* b2 = last ? nB : cB + (size_t)(t + 2) * kstep;
            const char* a3 = a2 + kstep; const char* b3 = b2 + kstep;
            if (last && has_next) S.a_ready(nxt);
            if constexpr (SP2) {
            PG8_LDB(B0, 0, 0); PG8_LDB(B1, 0, 1); PG8_SCHED; PG8_LDA(At, 0, 0); PG8_STAGE(PG8_SA(1, 1), a1 + hstepA, voffA);
            PG8_WAIT_V(8); PG8_WAIT_L(0); PG8_BAR; PG8_MMA(0, 0, At, B0); PG8_MMA(0, 1, At, B1); PG8_BAR; PG8_SCHED;
            PG8_LDA(At, 0, 1); PG8_STAGE(PG8_SB(0, 0), b2, voffB); PG8_STAGE(PG8_SB(0, 1), b2 + hstep, voffB); PG8_STAGE(PG8_SA(0, 0), a2, voffA);
            PG8_WAIT_V(8); PG8_WAIT_L(0); PG8_BAR; PG8_MMA(1, 0, At, B0); PG8_MMA(1, 1, At, B1); PG8_BAR; PG8_SCHED;
            PG8_LDB(B0, 1, 0); PG8_LDB(B1, 1, 1); PG8_SCHED; PG8_LDA(At, 1, 0); PG8_STAGE(PG8_SA(0, 1), a2 + hstepA, voffA);
            PG8_WAIT_V(8); PG8_WAIT_L(0); PG8_BAR; PG8_MMA(0, 0, At, B0); PG8_MMA(0, 1, At, B1); PG8_BAR; PG8_SCHED;
            PG8_LDA(At, 1, 1); PG8_STAGE(PG8_SB(1, 0), b3, voffB); PG8_STAGE(PG8_SB(1, 1), b3 + hstep, voffB); PG8_STAGE(PG8_SA(1, 0), a3, voffA);
            PG8_WAIT_V(8); PG8_WAIT_L(0); PG8_BAR; PG8_MMA(1, 0, At, B0); PG8_MMA(1, 1, At, B1); PG8_BAR; PG8_SCHED;
            } else {
            PG8_LDB(B0, 0, 0); PG8_SCHED; PG8_LDA(At, 0, 0); PG8_STAGE(PG8_SA(1, 1), a1 + hstepA, voffA);
            PG8_WAIT_L(8); PG8_BAR; PG8_WAIT_L(0); PG8_MMA(0, 0, At, B0); PG8_BAR; PG8_SCHED;
            PG8_LDB(B1, 0, 1); PG8_STAGE(PG8_SB(0, 0), b2, voffB);
            PG8_BAR; PG8_WAIT_L(0); PG8_MMA(0, 1, At, B1); PG8_BAR;
            PG8_LDA(At, 0, 1); PG8_STAGE(PG8_SA(0, 0), a2, voffA);
            PG8_BAR; PG8_WAIT_L(0); PG8_MMA(1, 0, At, B0); PG8_BAR; PG8_SCHED;
            PG8_STAGE(PG8_SB(0, 1), b2 + hstep, voffB);
            PG8_WAIT_V(6); PG8_BAR; PG8_MMA(1, 1, At, B1); PG8_BAR;
            PG8_LDB(B0, 1, 0); PG8_SCHED; PG8_LDA(At, 1, 0); PG8_STAGE(PG8_SA(0, 1), a2 + hstepA, voffA);
            PG8_WAIT_L(8); PG8_BAR; PG8_WAIT_L(0); PG8_MMA(0, 0, At, B0); PG8_BAR; PG8_SCHED;
            PG8_LDB(B1, 1, 1); PG8_STAGE(PG8_SB(1, 0), b3, voffB);
            PG8_BAR; PG8_WAIT_L(0); PG8_MMA(0, 1, At, B1); PG8_BAR;
            PG8_LDA(At, 1, 1); PG8_STAGE(PG8_SA(1, 0), a3, voffA);
            PG8_BAR; PG8_WAIT_L(0); PG8_MMA(1, 0, At, B0); PG8_BAR; PG8_SCHED;
            PG8_STAGE(PG8_SB(1, 1), b3 + hstep, voffB);
            PG8_WAIT_V(6); PG8_BAR; PG8_MMA(1, 1, At, B1); PG8_BAR;
            }
        }
        if constexpr (ALIGN_EPI) { if (wr == 0) PG8_BAR; }
        if constexpr (!Epi::AFTER_DRAIN) { E(acc, cur, wr, wc, fr, fq); S.done(cur); }
        if (!has_next) break;
#pragma unroll
        for (int a = 0; a < 2; ++a)
#pragma unroll
            for (int b = 0; b < 2; ++b)
#pragma unroll
                for (int m = 0; m < 4; ++m)
#pragma unroll
                    for (int n = 0; n < 2; ++n) acc[a][b][m][n] = (f32x4){0.f, 0.f, 0.f, 0.f};
        cur = nxt; cA = nA; cB = nB; ++ui;
        if constexpr (ALIGN_EPI) { if (wr == 1) PG8_BAR; }
    }
    PG8_WAIT_V(0);
    if constexpr (!ALIGN_EPI) { if (wr == 0) PG8_BAR; }
    PG8_BAR;
    if constexpr (Epi::AFTER_DRAIN) { E.fused(acc, cur, wr, wc, fr, fq, lds, wid, lane); S.done(cur); }
#undef PG8_ACOL
#undef PG8_SA
#undef PG8_SB
#undef PG8_STAGE
#undef PG8_LDA
#undef PG8_LDB
#undef PG8_MMA
#undef PG8_WAIT_V
#undef PG8_WAIT_L
#undef PG8_BAR
#undef PG8_SCHED
}
}
#define LAS __attribute__((address_space(3)))
typedef unsigned short bf16;
typedef unsigned u32x4 __attribute__((ext_vector_type(4)));
typedef unsigned u32x2 __attribute__((ext_vector_type(2)));
typedef float f32x4 __attribute__((ext_vector_type(4)));
typedef short bf16x8 __attribute__((ext_vector_type(8)));
constexpr int NB = 8, TL = 4096, DM = 1024, CTXL = 256;
constexpr int ML = NB * TL, MC = NB * CTXL, MT = ML + MC;
constexpr int NIN = 3488, NINP = 3584, FF = 2816, NLO = 2560, KLO = 384, KLB = 128, MODN = 6144;
constexpr int PC_K = 512, PC_V = 1024, PC_LORA = 1536, PC_GQ = 1920, PC_GK = 2176, PC_GV = 2432, PC_GLF = 2944, PC_GOG = 2976;
constexpr int NSLOT = 68;
constexpr size_t MiB = 1u << 20;
constexpr size_t WS_WIN = 1 * MiB, WS_WOUT = 8 * MiB, WS_WFFI = 10 * MiB, WS_WFFO = 21 * MiB, WS_WLORA = 27 * MiB, WS_MOD = 29 * MiB, WS_GAM = 30 * MiB;
constexpr size_t WS_P = 32 * MiB, WS_XN = 270 * MiB, WS_WAG = 270 * MiB, WS_GS = 440 * MiB, WS_END = 508 * MiB;
constexpr size_t WS_H = 32 * MiB, WS_H2 = 96 * MiB, WS_XN2 = 160 * MiB, WS_HMID = 270 * MiB;
static_assert(WS_P + (size_t)MT * NINP * 2 <= WS_XN && WS_WAG + (size_t)MT * NLO * 2 <= WS_GS && WS_GS + (size_t)NB * 4 * 2 * NSLOT * 16384 <= WS_END, "ws map");
static_assert(WS_XN2 + (size_t)ML * DM * 2 <= WS_HMID && WS_HMID + (size_t)ML * FF * 2 <= WS_END && WS_GAM + (size_t)NB * 4 * 2 * NSLOT * 64 * 4 <= WS_P, "ws map 2");
constexpr int LDS_BYTES = 147456;

struct Args { const float* in[27]; float* out; unsigned char* ws; };

#define LDS_WAIT() asm volatile("s_waitcnt lgkmcnt(0)" ::: "memory")
__device__ __forceinline__ unsigned pk2(float lo, float hi) { return pg8::cvt_pk_bf16(lo, hi); }
__device__ __forceinline__ float bflo(unsigned u) { return __uint_as_float(u << 16); }
__device__ __forceinline__ float bfhi(unsigned u) { return __uint_as_float(u & 0xffff0000u); }
__device__ __forceinline__ float bf1(bf16 u) { return __uint_as_float((unsigned)u << 16); }
__device__ __forceinline__ float wave_sum(float v) {
#pragma unroll
    for (int o = 1; o < 64; o <<= 1) v += __shfl_xor(v, o);
    return v;
}
template <int CTRL> __device__ __forceinline__ float dppf(float x) { return __builtin_bit_cast(float, __builtin_amdgcn_update_dpp(0, __builtin_bit_cast(int, x), CTRL, 0xF, 0xF, true)); }
__device__ __forceinline__ float red8(float x) { x += dppf<0xB1>(x); x += dppf<0x4E>(x); x += dppf<0x141>(x); return x; }
__device__ __forceinline__ float red16(float x) { x = red8(x); x += dppf<0x140>(x); return x; }
__device__ __forceinline__ float sigm(float v) { return __builtin_amdgcn_rcpf(1.0f + __expf(-v)); }
__device__ __forceinline__ float logsigm(float x) { return fminf(x, 0.f) - __logf(1.0f + __expf(-fabsf(x))); }

struct Nb4 { int n0, n1, n2, n3; };
__device__ __forceinline__ Nb4 neighbors(int R) {
    Nb4 n;
    if (R < ML) { const int t = R & (TL - 1), gc = t & 63, gr = t >> 6; n.n0 = gc > 0 ? R - 1 : -1; n.n1 = gc < 63 ? R + 1 : -1; n.n2 = gr > 0 ? R - 64 : -1; n.n3 = gr < 63 ? R + 64 : -1; }
    else { const int t = (R - ML) & (CTXL - 1); const int pv = t > 0 ? R - 1 : -1, nx = t < CTXL - 1 ? R + 1 : -1; n.n0 = pv; n.n1 = nx; n.n2 = pv; n.n3 = nx; }
    return n;
}
struct Raw5 { u32x4 o, a, b, c, d; };
__device__ __forceinline__ u32x4 ldrow(const bf16* P, int R, int col) { return R >= 0 ? *(const u32x4*)(P + (size_t)R * NINP + col) : (u32x4){0u, 0u, 0u, 0u}; }
__device__ __forceinline__ Raw5 load_raw5(const bf16* P, int R, const Nb4& nb, int col) {
    Raw5 r; r.o = ldrow(P, R, col); r.a = ldrow(P, nb.n0, col); r.b = ldrow(P, nb.n1, col); r.c = ldrow(P, nb.n2, col); r.d = ldrow(P, nb.n3, col); return r;
}
__device__ __forceinline__ float lerpf_(float p, float s, float m) { return p + (s - p) * m; }
__device__ __forceinline__ void xm8(const Raw5& r, const float* mu, float (&o)[8]) {
    const f32x4 m0 = *(const f32x4*)mu, m1 = *(const f32x4*)(mu + 4);
    o[0] = lerpf_(bflo(r.o.x), bflo(r.a.x), m0[0]); o[1] = lerpf_(bfhi(r.o.x), bfhi(r.b.x), m0[1]);
    o[2] = lerpf_(bflo(r.o.y), bflo(r.c.y), m0[2]); o[3] = lerpf_(bfhi(r.o.y), bfhi(r.d.y), m0[3]);
    o[4] = lerpf_(bflo(r.o.z), bflo(r.a.z), m1[0]); o[5] = lerpf_(bfhi(r.o.z), bfhi(r.b.z), m1[1]);
    o[6] = lerpf_(bflo(r.o.w), bflo(r.c.w), m1[2]); o[7] = lerpf_(bfhi(r.o.w), bfhi(r.d.w), m1[3]);
}
__device__ __forceinline__ void unpack8(const u32x4& v, float (&o)[8]) {
    o[0] = bflo(v.x); o[1] = bfhi(v.x); o[2] = bflo(v.y); o[3] = bfhi(v.y); o[4] = bflo(v.z); o[5] = bfhi(v.z); o[6] = bflo(v.w); o[7] = bfhi(v.w);
}
__device__ __forceinline__ u32x4 pack8(const float (&o)[8]) { u32x4 w; w.x = pk2(o[0], o[1]); w.y = pk2(o[2], o[3]); w.z = pk2(o[4], o[5]); w.w = pk2(o[6], o[7]); return w; }

__device__ __forceinline__ void transpose_item(const float* W, int N, bf16* WT, int ldk, int koff, int row_base, bool perm, LAS float* scr, int item, int lane) {
    const int nblk = N / 32, kb = item / nblk, nbk = item % nblk, k0 = 64 * kb, n0 = 32 * nbk;
#pragma unroll 8
    for (int i = 0; i < 32; ++i) { const int kk = 2 * i + (lane >> 5); scr[kk * 33 + (lane & 31)] = W[(size_t)(k0 + kk) * N + n0 + (lane & 31)]; }
    LDS_WAIT(); asm volatile("" ::: "memory");
    const int c = lane & 7;
#pragma unroll
    for (int j = 0; j < 4; ++j) { const int n = (lane >> 3) + 8 * j; const LAS float* s = scr + (8 * c) * 33 + n;
        u32x4 o; o.x = pk2(s[0 * 33], s[1 * 33]); o.y = pk2(s[2 * 33], s[3 * 33]); o.z = pk2(s[4 * 33], s[5 * 33]); o.w = pk2(s[6 * 33], s[7 * 33]);
        const int nn = n0 + n; const int drow = perm ? (nn < FF ? 8 * (nn >> 2) + (nn & 3) : 8 * ((nn - FF) >> 2) + 4 + ((nn - FF) & 3)) : nn;
        *(u32x4*)(WT + (size_t)(row_base + drow) * ldk + koff + k0 + 8 * c) = o; }
    LDS_WAIT(); asm volatile("" ::: "memory");
}
__device__ __forceinline__ void phase0(const Args& a, LAS unsigned char* lds, int tid, int lane, int wave) {
    unsigned char* ws = a.ws;
    const int G = gridDim.x, bx = blockIdx.x;
    if (bx < 96) {
        LAS float* red = (LAS float*)lds; LAS float* scs = (LAS float*)(lds + 32768);
        const float* c = a.in[1]; const float* cc = a.in[3]; const float* wm = a.in[4]; const float* bm = a.in[5]; float* mod = (float*)(ws + WS_MOD);
        for (int i = tid; i < 9 * 1024; i += 512) { const float v = i < 8192 ? c[i] : cc[i - 8192]; scs[i] = v * sigm(v); }
        __syncthreads();
        for (int cgp = bx; cgp < 96; cgp += G) {
            const int col = cgp * 64 + lane; float acc[9];
#pragma unroll
            for (int r = 0; r < 9; ++r) acc[r] = 0.f;
            for (int k = wave * 128; k < wave * 128 + 128; ++k) { const float wv = wm[(size_t)k * MODN + col];
#pragma unroll
                for (int r = 0; r < 9; ++r) acc[r] += scs[r * 1024 + k] * wv; }
#pragma unroll
            for (int r = 0; r < 9; ++r) red[(wave * 9 + r) * 64 + lane] = acc[r];
            __syncthreads();
            for (int idx = tid; idx < 576; idx += 512) { const int r = idx >> 6, l = idx & 63; float s = bm[cgp * 64 + l];
#pragma unroll
                for (int w = 0; w < 8; ++w) s += red[(w * 9 + r) * 64 + l];
                mod[r * MODN + cgp * 64 + l] = s; }
            __syncthreads();
        }
    }
    {
        LAS float* scr = (LAS float*)(lds + wave * 16384);
        const int gw = bx * 8 + wave, NGW = G * 8;
        constexpr int I_IN = 16 * (NIN / 32), I_OUT = 16 * 32, I_FFI = 16 * (2 * FF / 32), I_FFO = (FF / 64) * 32, I_L = 16, I_G = 32;
        constexpr int NITEMS = I_IN + I_OUT + I_FFI + I_FFO + 4 * I_L + I_G;
        bf16* win = (bf16*)(ws + WS_WIN); bf16* wout = (bf16*)(ws + WS_WOUT); bf16* wffi = (bf16*)(ws + WS_WFFI); bf16* wffo = (bf16*)(ws + WS_WFFO); bf16* wlo = (bf16*)(ws + WS_WLORA);
        for (int it = gw; it < NITEMS; it += NGW) {
            int r = it;
            if (r < I_IN) { transpose_item(a.in[7], NIN, win, DM, 0, 0, false, scr, r, lane); continue; } r -= I_IN;
            if (r < I_OUT) { transpose_item(a.in[22], DM, wout, DM, 0, 0, false, scr, r, lane); continue; } r -= I_OUT;
            if (r < I_FFI) { transpose_item(a.in[24], 2 * FF, wffi, DM, 0, 0, true, scr, r, lane); continue; } r -= I_FFI;
            if (r < I_FFO) { transpose_item(a.in[25], DM, wffo, FF, 0, 0, false, scr, r, lane); continue; } r -= I_FFO;
            if (r < 2 * I_L) { const int d = r / I_L; transpose_item(a.in[10] + (size_t)d * 64 * 512, 512, wlo, KLB, 64 * d, 512 * d, false, scr, r % I_L, lane); continue; } r -= 2 * I_L;
            if (r < 2 * I_L) { const int d = r / I_L; transpose_item(a.in[12] + (size_t)d * 64 * 512, 512, wlo, KLB, 64 * d, 1024 + 512 * d, false, scr, r % I_L, lane); continue; } r -= 2 * I_L;
            transpose_item(a.in[13], 512, wlo, KLB, 0, 2048, false, scr, r, lane);
        }
        const int gt = bx * 512 + tid, NT = G * 512;
        const u32x4 z4 = (u32x4){0u, 0u, 0u, 0u};
        for (int i = gt; i < (NINP - NIN) * DM / 8; i += NT) *(u32x4*)(win + (size_t)NIN * DM + (size_t)i * 8) = z4;
        for (int i = gt; i < 2048 * 8; i += NT) { const int n = i >> 3, kc = i & 7, blk = n >> 9;
            *(u32x4*)(wlo + (size_t)n * KLB + ((blk & 1) ? 0 : 64) + 8 * kc) = z4; }
    }
}
struct NormRow { f32x4 v[4]; };
__device__ __forceinline__ NormRow norm_load(const float* src, int lane) { NormRow r; const f32x4* xr = (const f32x4*)src + lane;
#pragma unroll
    for (int j = 0; j < 4; ++j) r.v[j] = xr[64 * j];
    return r; }
template <int MODE> __device__ __forceinline__ void norm_finish(const NormRow& r, const float* g, const float* sh, const float* sc, void* dst, int lane) {
    float s = 0.f;
#pragma unroll
    for (int j = 0; j < 4; ++j) s += (r.v[j].x * r.v[j].x + r.v[j].y * r.v[j].y) + (r.v[j].z * r.v[j].z + r.v[j].w * r.v[j].w);
    const float rstd = rsqrtf(wave_sum(s) * (1.f / DM) + 1e-6f);
#pragma unroll
    for (int j = 0; j < 4; ++j) { const int idx = 4 * lane + 256 * j; f32x4 y = r.v[j] * rstd * *(const f32x4*)(g + idx);
        if (MODE == 0) { y = y * (*(const f32x4*)(sc + idx) + 1.0f) + *(const f32x4*)(sh + idx);
            u32x2 w; w.x = pk2(y.x, y.y); w.y = pk2(y.z, y.w); *(u32x2*)((bf16*)dst + idx) = w; }
        else *(f32x4*)((float*)dst + idx) = y; }
}
struct NormRowB { u32x4 v[2]; };
__device__ __forceinline__ NormRowB normb_load(const bf16* src, int lane) { NormRowB r; r.v[0] = *(const u32x4*)(src + 8 * lane); r.v[1] = *(const u32x4*)(src + 512 + 8 * lane); return r; }
__device__ __forceinline__ void normb_finish(const NormRowB& r, const float* g, const float* sh, const float* sc, bf16* dst, int lane) {
    float x[2][8]; unpack8(r.v[0], x[0]); unpack8(r.v[1], x[1]); float s = 0.f;
#pragma unroll
    for (int j = 0; j < 2; ++j)
#pragma unroll
        for (int e = 0; e < 8; ++e) s += x[j][e] * x[j][e];
    const float rstd = rsqrtf(wave_sum(s) * (1.f / DM) + 1e-6f);
#pragma unroll
    for (int j = 0; j < 2; ++j) { const int idx = 8 * lane + 512 * j; float y[8];
        const f32x4 g0 = *(const f32x4*)(g + idx), g1 = *(const f32x4*)(g + idx + 4), c0 = *(const f32x4*)(sc + idx), c1 = *(const f32x4*)(sc + idx + 4), h0 = *(const f32x4*)(sh + idx), h1 = *(const f32x4*)(sh + idx + 4);
#pragma unroll
        for (int e = 0; e < 4; ++e) { y[e] = x[j][e] * rstd * g0[e] * (c0[e] + 1.0f) + h0[e]; y[4 + e] = x[j][4 + e] * rstd * g1[e] * (c1[e] + 1.0f) + h1[e]; }
        *(u32x4*)(dst + idx) = pack8(y); }
}
__device__ __forceinline__ void normb_final(const NormRowB& r, const float* g, float* dst, int lane) {
    float x[2][8]; unpack8(r.v[0], x[0]); unpack8(r.v[1], x[1]); float s = 0.f;
#pragma unroll
    for (int j = 0; j < 2; ++j)
#pragma unroll
        for (int e = 0; e < 8; ++e) s += x[j][e] * x[j][e];
    const float rstd = rsqrtf(wave_sum(s) * (1.f / DM) + 1e-6f);
#pragma unroll
    for (int j = 0; j < 2; ++j) { const int idx = 8 * lane + 512 * j; const f32x4 g0 = *(const f32x4*)(g + idx), g1 = *(const f32x4*)(g + idx + 4);
        *(f32x4*)(dst + idx) = (f32x4){x[j][0] * rstd * g0[0], x[j][1] * rstd * g0[1], x[j][2] * rstd * g0[2], x[j][3] * rstd * g0[3]};
        *(f32x4*)(dst + idx + 4) = (f32x4){x[j][4] * rstd * g1[0], x[j][5] * rstd * g1[1], x[j][6] * rstd * g1[2], x[j][7] * rstd * g1[3]}; }
}
__device__ __forceinline__ void phase_la(const bf16* P, const float* mu, bf16* LA, int lane, int gw, int NGW) {
    for (int R = gw; R < MT; R += NGW) {
        if (lane < 48) {
            const int col = PC_LORA + 8 * lane; const Nb4 nb = neighbors(R);
            const Raw5 rw = load_raw5(P, R, nb, col); float x[8]; xm8(rw, mu + col, x);
            if (lane < 16) {
#pragma unroll
                for (int e = 0; e < 8; ++e) x[e] = 1.0f - 2.0f * __builtin_amdgcn_rcpf(__expf(2.0f * x[e]) + 1.0f); }
            else if (lane >= 32) {
#pragma unroll
                for (int e = 0; e < 8; ++e) x[e] = sigm(x[e]); }
            *(u32x4*)(LA + (size_t)R * KLO + 8 * lane) = pack8(x);
        }
    }
}
__device__ __forceinline__ int gla_row(int b, int dir, int slot, int i) {
    if (slot < 4) { const int base = dir ? (192 - 64 * slot) : 64 * slot; return ML + b * CTXL + base + i; }
    const int j = slot - 4; const int col = dir ? 63 - j : j; return b * TL + i * 64 + col;
}
constexpr int GL_LG = 0, GL_QS = 16384, GL_KS = 25600, GL_VT = 34816, GL_AM = 53248, GL_SSQ = 62464, GL_TOT = 64512, GL_A2S = 66560, GLP = 72;
struct GlaRaw { u32x4 l0, l1, q, k, v0, v1; };
template <bool NEEDQ> __device__ __forceinline__ GlaRaw gla_prefetch(const bf16* P, int b, int h, int dir, int slot, int tid) {
    const int i = tid >> 3, t8 = tid & 7; const bf16* row = P + (size_t)gla_row(b, dir, slot, i) * NINP; GlaRaw g;
    g.l0 = *(const u32x4*)(row + PC_GLF + 16 * dir); g.l1 = *(const u32x4*)(row + PC_GLF + 16 * dir + 8);
    g.k = *(const u32x4*)(row + PC_GK + h * 64 + 8 * t8); g.q = NEEDQ ? *(const u32x4*)(row + PC_GQ + h * 64 + 8 * t8) : g.k;
    g.v0 = *(const u32x4*)(row + PC_GV + h * 128 + 16 * t8); g.v1 = *(const u32x4*)(row + PC_GV + h * 128 + 16 * t8 + 8);
    return g;
}
__device__ __forceinline__ void gla_stage_a2(const float* ga2, LAS float* a2s, int tid) {
    for (int idx = tid * 4; idx < 8192; idx += 2048) { const int dh = idx >> 10, r = (idx >> 6) & 15, d = idx & 63;
        *(LAS f32x4*)(a2s + idx) = *(const f32x4*)(ga2 + (size_t)(dh >> 2) * 4096 + r * 256 + (dh & 3) * 64 + d); }
    __syncthreads();
}
__device__ __forceinline__ void gla_gates(const u32x4& l0, const u32x4& l1, const LAS float* a2s, const float* gab, int h, int dir, LAS float* lg, int tid) {
    const int i = tid >> 3, d0 = 8 * (tid & 7);
    float lr[16]; { float t0[8], t1[8]; unpack8(l0, t0); unpack8(l1, t1);
#pragma unroll
        for (int e = 0; e < 8; ++e) { lr[e] = t0[e]; lr[8 + e] = t1[e]; } }
    const LAS float* a2p = a2s + (dir * 4 + h) * 1024 + d0; const float* abp = gab + dir * 256 + h * 64 + d0;
    f32x4 x0 = *(const f32x4*)abp, x1 = *(const f32x4*)(abp + 4);
#pragma unroll
    for (int r = 0; r < 16; ++r) { x0 += *(const LAS f32x4*)(a2p + r * 64) * lr[r]; x1 += *(const LAS f32x4*)(a2p + r * 64 + 4) * lr[r]; }
    f32x4 y0, y1;
#pragma unroll
    for (int e = 0; e < 4; ++e) { y0[e] = logsigm(x0[e]) * 0.0625f; y1[e] = logsigm(x1[e]) * 0.0625f; }
    *(LAS f32x4*)(lg + i * 64 + d0) = y0; *(LAS f32x4*)(lg + i * 64 + d0 + 4) = y1;
    __syncthreads();
    {
        LAS float* tot = lg + (GL_TOT / 4); const int g = __builtin_amdgcn_readfirstlane(tid >> 6), d = tid & 63; float pr[8]; float run = 0.f;
        if (dir == 0) {
#pragma unroll
            for (int r = 0; r < 8; ++r) { run += lg[(8 * g + r) * 64 + d]; pr[r] = run; } }
        else {
#pragma unroll
            for (int r = 7; r >= 0; --r) { run += lg[(8 * g + r) * 64 + d]; pr[r] = run; } }
        tot[g * 64 + d] = run;
        __syncthreads();
        float off = 0.f;
#pragma unroll
        for (int gg = 0; gg < 8; ++gg) { const float tv = tot[gg * 64 + d]; off += ((dir == 0) ? (gg < g) : (gg > g)) ? tv : 0.f; }
#pragma unroll
        for (int r = 0; r < 8; ++r) lg[(8 * g + r) * 64 + d] = pr[r] + off;
    }
    __syncthreads();
}
__device__ __forceinline__ void gla_store_vT(const u32x4& v0, const u32x4& v1, LAS bf16* vT, int tid) {
    const int j = tid >> 3, e0 = 16 * (tid & 7);
    const unsigned w[8] = {v0.x, v0.y, v0.z, v0.w, v1.x, v1.y, v1.z, v1.w};
    const int jp = j ^ (8 * (tid & 7));
#pragma unroll
    for (int q = 0; q < 8; ++q) { vT[(e0 + 2 * q) * GLP + jp] = (bf16)(w[q] & 0xffffu); vT[(e0 + 2 * q + 1) * GLP + jp] = (bf16)(w[q] >> 16); }
}
__device__ __forceinline__ void gla_pass_a(const bf16* P, const float* ga2, const float* gab, bf16* GS, float* GAM, LAS unsigned char* lds, int tid, int lane, int wave) {
    LAS float* lg = (LAS float*)(lds + GL_LG); LAS bf16* kdT = (LAS bf16*)(lds + GL_KS); LAS bf16* vT = (LAS bf16*)(lds + GL_VT); LAS float* a2s = (LAS float*)(lds + GL_A2S);
    constexpr int NU = NB * 4 * 2 * NSLOT; const int G = gridDim.x;
    gla_stage_a2(ga2, a2s, tid);
    GlaRaw nxt;
    { const int unit = blockIdx.x; if (unit < NU) nxt = gla_prefetch<false>(P, unit / (8 * NSLOT), (unit / (2 * NSLOT)) & 3, (unit / NSLOT) & 1, unit % NSLOT, tid); }
    for (int unit = blockIdx.x; unit < NU; unit += G) {
        const int slot = unit % NSLOT, dir = (unit / NSLOT) & 1, h = (unit / (2 * NSLOT)) & 3;
        const GlaRaw cur = nxt;
        gla_gates(cur.l0, cur.l1, a2s, gab, h, dir, lg, tid);
        const int lastrow = dir ? 0 : 63;
        { const int j = tid >> 3, d0 = 8 * (tid & 7);
          float k[8]; unpack8(cur.k, k);
#pragma unroll
          for (int e = 0; e < 8; ++e) { const float v = k[e] * __expf(lg[lastrow * 64 + d0 + e] - lg[j * 64 + d0 + e]); kdT[(d0 + e) * GLP + (j ^ d0)] = (bf16)(pk2(v, 0.f) & 0xffffu); } }
        gla_store_vT(cur.v0, cur.v1, vT, tid);
        if (tid < 64) GAM[(size_t)unit * 64 + tid] = __expf(lg[lastrow * 64 + tid]);
        { const int un = unit + G; if (un < NU) nxt = gla_prefetch<false>(P, un / (8 * NSLOT), (un / (2 * NSLOT)) & 3, (un / NSLOT) & 1, un % NSLOT, tid); }
        __syncthreads();
        f32x4 acc[4];
#pragma unroll
        for (int m = 0; m < 4; ++m) acc[m] = (f32x4){0.f, 0.f, 0.f, 0.f};
#pragma unroll
        for (int ks = 0; ks < 2; ++ks) { const bf16x8 bfr = *(const LAS bf16x8*)(vT + (16 * wave + (lane & 15)) * GLP + ((ks * 32 + (lane >> 4) * 8) ^ (8 * wave)));
#pragma unroll
            for (int m = 0; m < 4; ++m) { const bf16x8 afr = *(const LAS bf16x8*)(kdT + (16 * m + (lane & 15)) * GLP + ((ks * 32 + (lane >> 4) * 8) ^ (8 * (2 * m + ((lane >> 3) & 1)))));
                acc[m] = __builtin_amdgcn_mfma_f32_16x16x32_bf16(afr, bfr, acc[m], 0, 0, 0); } }
        bf16* dst = GS + (size_t)unit * 8192 + (size_t)(16 * wave + (lane & 15)) * 64 + (lane >> 4) * 4;
#pragma unroll
        for (int m = 0; m < 4; ++m) { u32x2 w; w.x = pk2(acc[m][0], acc[m][1]); w.y = pk2(acc[m][2], acc[m][3]); *(u32x2*)(dst + 16 * m) = w; }
        __syncthreads();
    }
}
__device__ __forceinline__ void gla_pass_b(bf16* GS, const float* GAM, int tid) {
    const int gt = blockIdx.x * 512 + tid;
    for (int wi = gt; wi < 64 * 2048; wi += gridDim.x * 512) {
        const int chain = wi >> 11, off = (wi & 2047) * 4, d = off & 63;
        bf16* base = GS + (size_t)chain * NSLOT * 8192 + off; const float* gb = GAM + (size_t)chain * NSLOT * 64 + d;
        f32x4 S = (f32x4){0.f, 0.f, 0.f, 0.f};
#pragma unroll 1
        for (int s0 = 0; s0 < NSLOT; s0 += 17) {
            u32x2 kv[17]; f32x4 gm[17];
#pragma unroll
            for (int q = 0; q < 17; ++q) { kv[q] = *(const u32x2*)(base + (size_t)(s0 + q) * 8192); gm[q] = *(const f32x4*)(gb + (s0 + q) * 64); }
#pragma unroll
            for (int q = 0; q < 17; ++q) { u32x2 o; o.x = pk2(S[0], S[1]); o.y = pk2(S[2], S[3]); *(u32x2*)(base + (size_t)(s0 + q) * 8192) = o;
                const f32x4 kf = (f32x4){bflo(kv[q].x), bfhi(kv[q].x), bflo(kv[q].y), bfhi(kv[q].y)}; S = gm[q] * S + kf; }
        }
    }
}
constexpr int C2_LG = 0, C2_QS = 32768, C2_KS = 51200, C2_VT = 69632, C2_AM = 88064, C2_SSQ = 97280, C2_TOT = 99328, C2_A2S = 103424;
struct GlaRaw2 { u32x4 lf0, lf1, lb0, lb1, q, k, v0, v1; };
__device__ __forceinline__ GlaRaw2 gla_prefetch2(const bf16* P, int b, int h, int j, int tid) {
    const int i = tid >> 3, t8 = tid & 7; const bf16* row = P + (size_t)(b * TL + i * 64 + j) * NINP; GlaRaw2 g;
    g.lf0 = *(const u32x4*)(row + PC_GLF); g.lf1 = *(const u32x4*)(row + PC_GLF + 8); g.lb0 = *(const u32x4*)(row + PC_GLF + 16); g.lb1 = *(const u32x4*)(row + PC_GLF + 24);
    g.q = *(const u32x4*)(row + PC_GQ + h * 64 + 8 * t8); g.k = *(const u32x4*)(row + PC_GK + h * 64 + 8 * t8);
    g.v0 = *(const u32x4*)(row + PC_GV + h * 128 + 16 * t8); g.v1 = *(const u32x4*)(row + PC_GV + h * 128 + 16 * t8 + 8);
    return g;
}
template <int DIR> __device__ __forceinline__ void gates_x(const u32x4& l0, const u32x4& l1, const LAS float* a2s, const float* gab, int h, LAS float* lg, int tid) {
    const int i = tid >> 3, d0 = 8 * (tid & 7);
    float lr[16]; { float t0[8], t1[8]; unpack8(l0, t0); unpack8(l1, t1);
#pragma unroll
        for (int e = 0; e < 8; ++e) { lr[e] = t0[e]; lr[8 + e] = t1[e]; } }
    const LAS float* a2p = a2s + (DIR * 4 + h) * 1024 + d0; const float* abp = gab + DIR * 256 + h * 64 + d0;
    f32x4 x0 = *(const f32x4*)abp, x1 = *(const f32x4*)(abp + 4);
#pragma unroll
    for (int r = 0; r < 16; ++r) { x0 += *(const LAS f32x4*)(a2p + r * 64) * lr[r]; x1 += *(const LAS f32x4*)(a2p + r * 64 + 4) * lr[r]; }
    f32x4 y0, y1;
#pragma unroll
    for (int e = 0; e < 4; ++e) { y0[e] = logsigm(x0[e]) * 0.0625f; y1[e] = logsigm(x1[e]) * 0.0625f; }
    *(LAS f32x4*)(lg + i * 64 + d0) = y0; *(LAS f32x4*)(lg + i * 64 + d0 + 4) = y1;
}
template <int DIR> __device__ __forceinline__ void gates_s1(const LAS float* lg, LAS float* tot, int g, int d, float (&pr)[8]) {
    float run = 0.f;
    if (DIR == 0) {
#pragma unroll
        for (int r = 0; r < 8; ++r) { run += lg[(8 * g + r) * 64 + d]; pr[r] = run; } }
    else {
#pragma unroll
        for (int r = 7; r >= 0; --r) { run += lg[(8 * g + r) * 64 + d]; pr[r] = run; } }
    tot[g * 64 + d] = run;
}
template <int DIR> __device__ __forceinline__ void gates_s2(LAS float* lg, const LAS float* tot, int g, int d, const float (&pr)[8]) {
    float off = 0.f;
#pragma unroll
    for (int gg = 0; gg < 8; ++gg) { const float tv = tot[gg * 64 + d]; off += ((DIR == 0) ? (gg < g) : (gg > g)) ? tv : 0.f; }
#pragma unroll
    for (int r = 0; r < 8; ++r) lg[(8 * g + r) * 64 + d] = pr[r] + off;
}
struct AsmS1 { Raw5 r, k; u32x4 a0, a1; };
struct AsmS2 { Raw5 v; u32x4 g, y0, y1; };
struct AsmCtx { const bf16* P; const bf16* WAG; const bf16* Y; const float* mu; const float* kaw; const float* rkw; const float* lnw; const float* lnb; bf16* Mx; };
__device__ __forceinline__ AsmS1 asm_s1_load(const AsmCtx& C, int R, int lane) { const int c = 8 * lane; const Nb4 nb = neighbors(R); AsmS1 x;
    x.r = load_raw5(C.P, R, nb, c); x.k = load_raw5(C.P, R, nb, PC_K + c); x.a0 = *(const u32x4*)(C.WAG + (size_t)R * NLO + 1024 + c); x.a1 = *(const u32x4*)(C.WAG + (size_t)R * NLO + 1536 + c); return x; }
__device__ __forceinline__ float asm_s1_finish(const AsmCtx& C, const AsmS1& x, int lane) { const int c = 8 * lane; float r[8], k[8], a0[8], a1[8];
    xm8(x.r, C.mu + c, r); xm8(x.k, C.mu + PC_K + c, k); unpack8(x.a0, a0); unpack8(x.a1, a1); float bs = 0.f;
#pragma unroll
    for (int q = 0; q < 8; ++q) bs += r[q] * (k[q] * (2.0f + (a0[q] + a1[q] - 2.0f) * C.kaw[c + q])) * C.rkw[c + q];
    return red8(bs); }
__device__ __forceinline__ AsmS2 asm_s2_load(const AsmCtx& C, int R, int lane) { const int c = 8 * lane; const Nb4 nb = neighbors(R); AsmS2 x;
    x.v = load_raw5(C.P, R, nb, PC_V + c); x.g = *(const u32x4*)(C.WAG + (size_t)R * NLO + 2048 + c); x.y0 = *(const u32x4*)(C.Y + (size_t)R * 512 + c); x.y1 = *(const u32x4*)(C.Y + ((size_t)ML + R) * 512 + c); return x; }
__device__ __forceinline__ void asm_s2_finish(const AsmCtx& C, const AsmS2& x, float bs, int R, int lane) { const int c = 8 * lane; float v[8], g[8], y[8], yb[8];
    xm8(x.v, C.mu + PC_V + c, v); unpack8(x.g, g); unpack8(x.y0, y); unpack8(x.y1, yb);
    float sm = 0.f;
#pragma unroll
    for (int q = 0; q < 8; ++q) { y[q] += yb[q]; sm += y[q]; }
    const float mean = red8(sm) * (1.f / 64.f); float sq = 0.f;
#pragma unroll
    for (int q = 0; q < 8; ++q) { const float d = y[q] - mean; sq += d * d; }
    const float rstd = rsqrtf(red8(sq) * (1.f / 64.f) + 64e-5f); float o[8];
#pragma unroll
    for (int q = 0; q < 8; ++q) o[q] = ((y[q] - mean) * rstd * C.lnw[c + q] + C.lnb[c + q] + bs * v[q]) * g[q];
    *(u32x4*)(C.Mx + (size_t)R * DM + c) = pack8(o); }
__device__ __forceinline__ void gla_pass_c(const bf16* P, const float* ga2, const float* gab, const float* gain, const bf16* GS, bf16* Mx, LAS unsigned char* lds, int tid, int lane, int wave, const AsmCtx& AC, int gw, int NGW) {
    LAS float* lg0 = (LAS float*)(lds + C2_LG); LAS float* lg1 = lg0 + 4096; LAS bf16* qs0 = (LAS bf16*)(lds + C2_QS); LAS bf16* qs1 = qs0 + 64 * GLP;
    LAS bf16* ks0 = (LAS bf16*)(lds + C2_KS); LAS bf16* ks1 = ks0 + 64 * GLP; LAS bf16* vT = (LAS bf16*)(lds + C2_VT); LAS bf16* am = (LAS bf16*)(lds + C2_AM);
    LAS float* ssq = (LAS float*)(lds + C2_SSQ); LAS float* tot0 = (LAS float*)(lds + C2_TOT); LAS float* tot1 = tot0 + 512; LAS float* a2s = (LAS float*)(lds + C2_A2S);
    constexpr int NU = NB * 64 * 4; const int G = gridDim.x;
    gla_stage_a2(ga2, a2s, tid);
    const int sg = __builtin_amdgcn_readfirstlane(tid >> 6), sd = tid & 63;
    GlaRaw2 nxt;
    { const int unit = blockIdx.x; if (unit < NU) nxt = gla_prefetch2(P, unit >> 8, unit & 3, (unit >> 2) & 63, tid); }
    int Ras = gw;
    for (int unit = blockIdx.x; unit < NU; unit += G) {
        const int h = unit & 3, j = (unit >> 2) & 63, b = unit >> 8;
        const int RA = Ras, RB = Ras + NGW; const bool hasA = RA < ML, hasB = RB < ML; const int RAc = hasA ? RA : gw, RBc = hasB ? RB : gw; Ras += 2 * NGW;
        const AsmS1 s1A = asm_s1_load(AC, RAc, lane);
        const int e = 16 * wave + (lane & 15);
        float ogv[4][4];
#pragma unroll
        for (int m = 0; m < 4; ++m)
#pragma unroll
            for (int jj = 0; jj < 4; ++jj) { const int i = 16 * m + (lane >> 4) * 4 + jj; ogv[m][jj] = bf1(P[(size_t)(b * TL + i * 64 + j) * NINP + PC_GOG + h * 128 + e]); }
        const GlaRaw2 cur = nxt;
        const size_t su0 = ((size_t)((b * 4 + h) * 2 + 0) * NSLOT + 4 + j) * 8192, su1 = ((size_t)((b * 4 + h) * 2 + 1) * NSLOT + 4 + (63 - j)) * 8192;
        const bf16x8 bs00 = *(const bf16x8*)(GS + su0 + (size_t)e * 64 + (lane >> 4) * 8), bs01 = *(const bf16x8*)(GS + su0 + (size_t)e * 64 + 32 + (lane >> 4) * 8);
        const bf16x8 bs10 = *(const bf16x8*)(GS + su1 + (size_t)e * 64 + (lane >> 4) * 8), bs11 = *(const bf16x8*)(GS + su1 + (size_t)e * 64 + 32 + (lane >> 4) * 8);
        gates_x<0>(cur.lf0, cur.lf1, a2s, gab, h, lg0, tid); gates_x<1>(cur.lb0, cur.lb1, a2s, gab, h, lg1, tid);
        __syncthreads();
        const float bsA = asm_s1_finish(AC, s1A, lane); const AsmS2 s2A = asm_s2_load(AC, RAc, lane);
        float pr0[8], pr1[8];
        gates_s1<0>(lg0, tot0, sg, sd, pr0); gates_s1<1>(lg1, tot1, sg, sd, pr1);
        __syncthreads();
        gates_s2<0>(lg0, tot0, sg, sd, pr0); gates_s2<1>(lg1, tot1, sg, sd, pr1);
        __syncthreads();
        { const int i = tid >> 3, d0 = 8 * (tid & 7);
          float q[8], k[8], q1[8], k1[8]; unpack8(cur.q, q); unpack8(cur.k, k);
#pragma unroll
          for (int ee = 0; ee < 8; ++ee) { const float b0 = lg0[i * 64 + d0 + ee], b1 = lg1[i * 64 + d0 + ee]; const float qq = q[ee] * 0.125f, kk = k[ee];
              q[ee] = qq * __expf(b0); k[ee] = kk * __expf(-b0); q1[ee] = qq * __expf(b1); k1[ee] = kk * __expf(-b1); }
          *(LAS u32x4*)(qs0 + i * GLP + d0) = pack8(q); *(LAS u32x4*)(ks0 + i * GLP + d0) = pack8(k);
          *(LAS u32x4*)(qs1 + i * GLP + d0) = pack8(q1); *(LAS u32x4*)(ks1 + i * GLP + d0) = pack8(k1); }
        gla_store_vT(cur.v0, cur.v1, vT, tid);
        { const int un = unit + G; if (un < NU) nxt = gla_prefetch2(P, un >> 8, un & 3, (un >> 2) & 63, tid); }
        __syncthreads();
        if (hasA) asm_s2_finish(AC, s2A, bsA, RAc, lane);
        const AsmS1 s1B = asm_s1_load(AC, RBc, lane);
        { const int mi = wave >> 1;
#pragma unroll
          for (int t = 0; t < 2; ++t) { const int nj = 2 * (wave & 1) + t; f32x4 acc0 = (f32x4){0.f, 0.f, 0.f, 0.f}, acc1 = acc0;
#pragma unroll
              for (int ks = 0; ks < 2; ++ks) { const int ao = (16 * mi + (lane & 15)) * GLP + ks * 32 + (lane >> 4) * 8, bo = (16 * nj + (lane & 15)) * GLP + ks * 32 + (lane >> 4) * 8;
                  acc0 = __builtin_amdgcn_mfma_f32_16x16x32_bf16(*(const LAS bf16x8*)(qs0 + ao), *(const LAS bf16x8*)(ks0 + bo), acc0, 0, 0, 0);
                  acc1 = __builtin_amdgcn_mfma_f32_16x16x32_bf16(*(const LAS bf16x8*)(qs1 + ao), *(const LAS bf16x8*)(ks1 + bo), acc1, 0, 0, 0); }
              const int cj = 16 * nj + (lane & 15);
#pragma unroll
              for (int jj = 0; jj < 4; ++jj) { const int ri = 16 * mi + (lane >> 4) * 4 + jj;
                  const float av = (cj <= ri ? acc0[jj] : 0.f) + (cj >= ri ? acc1[jj] : 0.f);
                  am[ri * GLP + cj] = (bf16)(pk2(av, 0.f) & 0xffffu); } } }
        __syncthreads();
        const float bsB = asm_s1_finish(AC, s1B, lane); const AsmS2 s2B = asm_s2_load(AC, RBc, lane);
        f32x4 oacc[4];
#pragma unroll
        for (int m = 0; m < 4; ++m) oacc[m] = (f32x4){0.f, 0.f, 0.f, 0.f};
#pragma unroll
        for (int ks = 0; ks < 2; ++ks) {
            const bf16x8 bv = *(const LAS bf16x8*)(vT + (16 * wave + (lane & 15)) * GLP + ((ks * 32 + (lane >> 4) * 8) ^ (8 * wave)));
            const bf16x8 b0 = ks ? bs01 : bs00, b1 = ks ? bs11 : bs10;
#pragma unroll
            for (int m = 0; m < 4; ++m) { const int ao = (16 * m + (lane & 15)) * GLP + ks * 32 + (lane >> 4) * 8;
                oacc[m] = __builtin_amdgcn_mfma_f32_16x16x32_bf16(*(const LAS bf16x8*)(am + ao), bv, oacc[m], 0, 0, 0);
                oacc[m] = __builtin_amdgcn_mfma_f32_16x16x32_bf16(*(const LAS bf16x8*)(qs0 + ao), b0, oacc[m], 0, 0, 0);
                oacc[m] = __builtin_amdgcn_mfma_f32_16x16x32_bf16(*(const LAS bf16x8*)(qs1 + ao), b1, oacc[m], 0, 0, 0); } }
#pragma unroll
        for (int m = 0; m < 4; ++m)
#pragma unroll
            for (int jj = 0; jj < 4; ++jj) { const float sq = red16(oacc[m][jj] * oacc[m][jj]); if ((lane & 15) == 0) ssq[wave * 64 + 16 * m + (lane >> 4) * 4 + jj] = sq; }
        __syncthreads();
        if (hasB) asm_s2_finish(AC, s2B, bsB, RBc, lane);
        const float gn = gain[e];
#pragma unroll
        for (int m = 0; m < 4; ++m)
#pragma unroll
            for (int jj = 0; jj < 4; ++jj) { const int i = 16 * m + (lane >> 4) * 4 + jj; float tt = 0.f;
#pragma unroll
                for (int w = 0; w < 8; ++w) tt += ssq[w * 64 + i];
                const int R = b * TL + i * 64 + j; const float og = ogv[m][jj];
                const float val = oacc[m][jj] * rsqrtf(tt * (1.f / 128.f) + 1e-5f) * gn * (og * sigm(og));
                Mx[(size_t)R * DM + 512 + h * 128 + e] = (bf16)(pk2(val, 0.f) & 0xffffu); }
        __syncthreads();
    }
    for (; Ras < ML; Ras += NGW) { const AsmS1 a1 = asm_s1_load(AC, Ras, lane); const float bb = asm_s1_finish(AC, a1, lane); const AsmS2 a2 = asm_s2_load(AC, Ras, lane); asm_s2_finish(AC, a2, bb, Ras, lane); }
}
struct RwRaw { Raw5 r, k, v; u32x4 e, a; };
__device__ __forceinline__ int rw_row(int b, int dir, int s, int j) {
    if (s < 4) return ML + b * CTXL + (dir ? 192 - 64 * s : 64 * s) + j;
    const int gr = dir ? 63 - (s - 4) : s - 4; return b * TL + gr * 64 + j;
}
__device__ __forceinline__ int rw_hrow(int b, int dir, int hc, int jj) { const int i = 32 * (hc & 1) + jj; return rw_row(b, dir, hc >> 1, dir ? 63 - i : i); }
__device__ __forceinline__ RwRaw rw_load(const bf16* P, const bf16* WAG, int b, int h, int dir, int hc, int t) {
    const int jj = t >> 3, ch0 = 8 * (t & 7); const int R = rw_hrow(b, dir, hc, jj); const Nb4 nb = neighbors(R);
    RwRaw x; x.r = load_raw5(P, R, nb, h * 64 + ch0); x.k = load_raw5(P, R, nb, PC_K + h * 64 + ch0); x.v = load_raw5(P, R, nb, PC_V + h * 64 + ch0);
    x.e = *(const u32x4*)(WAG + (size_t)R * NLO + dir * 512 + h * 64 + ch0); x.a = *(const u32x4*)(WAG + (size_t)R * NLO + 1024 + dir * 512 + h * 64 + ch0);
    return x;
}
__device__ __forceinline__ void rw_features(const RwRaw& x, const float* mu, const float* kkw, const float* kaw, int h, LAS float* feat, int t) {
    const int jj = t >> 3, ch0 = 8 * (t & 7), c = h * 64 + ch0;
    float r[8], k[8], v[8], e[8], a[8]; xm8(x.r, mu + c, r); xm8(x.k, mu + PC_K + c, k); xm8(x.v, mu + PC_V + c, v); unpack8(x.e, e); unpack8(x.a, a);
    const f32x4 kk0 = *(const f32x4*)(kkw + c), kk1 = *(const f32x4*)(kkw + c + 4), ka0 = *(const f32x4*)(kaw + c), ka1 = *(const f32x4*)(kaw + c + 4);
    float kk[8], ss = 0.f;
#pragma unroll
    for (int q = 0; q < 8; ++q) { kk[q] = k[q] * (q < 4 ? kk0[q & 3] : kk1[q & 3]); ss += kk[q] * kk[q]; }
    ss = red8(ss); const float inv = __builtin_amdgcn_rsqf(fmaxf(ss, 1e-24f));
    float w[8], kd[8], bd[8];
#pragma unroll
    for (int q = 0; q < 8; ++q) { const float kav = q < 4 ? ka0[q & 3] : ka1[q & 3]; kk[q] *= inv; w[q] = __expf(-e[q]); kd[q] = k[q] * (1.0f + (a[q] - 1.0f) * kav); bd[q] = kk[q] * a[q]; }
    const int tw = (t >> 3) & 7;
    float rin[8], rex[8];
#pragma unroll
    for (int q = 0; q < 8; ++q) { float cp = w[q];
        const float t1 = __shfl_up(cp, 8); cp = tw >= 1 ? cp * t1 : cp;
        const float t2 = __shfl_up(cp, 16); cp = tw >= 2 ? cp * t2 : cp;
        const float t4 = __shfl_up(cp, 32); cp = tw >= 4 ? cp * t4 : cp;
        const float pv = __shfl_up(cp, 8); rin[q] = cp; rex[q] = tw >= 1 ? pv : 1.0f; }
#pragma unroll
    for (int q = 0; q < 8; ++q) { const float ir = __builtin_amdgcn_rcpf(rin[q]); kk[q] *= rex[q]; bd[q] *= ir; kd[q] *= ir; r[q] *= rin[q]; }
    LAS float* f = feat + jj * 384 + ch0;
    *(LAS f32x4*)(f) = (f32x4){r[0], r[1], r[2], r[3]}; *(LAS f32x4*)(f + 4) = (f32x4){r[4], r[5], r[6], r[7]};
    *(LAS f32x4*)(f + 64) = (f32x4){rin[0], rin[1], rin[2], rin[3]}; *(LAS f32x4*)(f + 68) = (f32x4){rin[4], rin[5], rin[6], rin[7]};
    *(LAS f32x4*)(f + 128) = (f32x4){kd[0], kd[1], kd[2], kd[3]}; *(LAS f32x4*)(f + 132) = (f32x4){kd[4], kd[5], kd[6], kd[7]};
    *(LAS f32x4*)(f + 192) = (f32x4){kk[0], kk[1], kk[2], kk[3]}; *(LAS f32x4*)(f + 196) = (f32x4){kk[4], kk[5], kk[6], kk[7]};
    *(LAS f32x4*)(f + 256) = (f32x4){bd[0], bd[1], bd[2], bd[3]}; *(LAS f32x4*)(f + 260) = (f32x4){bd[4], bd[5], bd[6], bd[7]};
    *(LAS f32x4*)(f + 320) = (f32x4){v[0], v[1], v[2], v[3]}; *(LAS f32x4*)(f + 324) = (f32x4){v[4], v[5], v[6], v[7]};
}
typedef float f32x2 __attribute__((ext_vector_type(2)));
struct RwFeat { f32x2 r[4], kd[4], kk[4], bd[4]; float v; };
#define RW_LD2(dst, fj, off) { const f32x4 t0 = *(const LAS f32x4*)((fj) + (off) + c8), t1 = *(const LAS f32x4*)((fj) + (off) + c8 + 4); \
        dst[0] = (f32x2){t0.x, t0.y}; dst[1] = (f32x2){t0.z, t0.w}; dst[2] = (f32x2){t1.x, t1.y}; dst[3] = (f32x2){t1.z, t1.w}; }
__device__ __forceinline__ RwFeat rw_ldfeat(const LAS float* fj, int c8, int row) {
    RwFeat f;
    RW_LD2(f.kk, fj, 192) RW_LD2(f.bd, fj, 256) RW_LD2(f.kd, fj, 128) RW_LD2(f.r, fj, 0)
    f.v = fj[320 + row]; return f;
}
template <bool EMIT> __device__ __forceinline__ float rw_step(f32x2 (&S)[4], const RwFeat& f) {
    f32x2 pa = S[0] * f.kk[0], pb = S[1] * f.kk[1]; pa = S[2] * f.kk[2] + pa; pb = S[3] * f.kk[3] + pb; pa = pa + pb;
#pragma unroll
    for (int q = 0; q < 4; ++q) S[q] = f.kd[q] * f.v + S[q];
    const float sa = -red8(pa.x + pa.y);
#pragma unroll
    for (int q = 0; q < 4; ++q) S[q] = f.bd[q] * sa + S[q];
    if (!EMIT) return 0.f;
    f32x2 ya = S[0] * f.r[0], yb = S[1] * f.r[1]; ya = S[2] * f.r[2] + ya; yb = S[3] * f.r[3] + yb; ya = ya + yb;
    return red8(ya.x + ya.y);
}
__device__ __forceinline__ void rwkv_scan(const bf16* P, const bf16* WAG, const float* mu, const float* kkw, const float* kaw, bf16* Y, LAS unsigned char* lds, int tid, int lane, int wave, bf16* GS, const float* GAM) {
    LAS float* featb = (LAS float*)lds; LAS float* ybufb = (LAS float*)(lds + 98304);
    constexpr int NHC = 2 * NSLOT;
    for (int unit = blockIdx.x; unit < 256; unit += gridDim.x) {
        const int half = unit & 1, dir = (unit >> 1) & 1, h = (unit >> 2) & 7, b = unit >> 5;
        if (wave >= 4) {
            const int t = tid - 256;
            const int pb0 = blockIdx.x * 256 + t, pb1 = pb0 + 65536; const bool pb_on = gridDim.x == 256;
            bf16* gsA = GS + (size_t)(pb0 >> 11) * NSLOT * 8192 + (pb0 & 2047) * 4; const float* gmA = GAM + (size_t)(pb0 >> 11) * NSLOT * 64 + (((pb0 & 2047) * 4) & 63);
            bf16* gsB = GS + (size_t)(pb1 >> 11) * NSLOT * 8192 + (pb1 & 2047) * 4; const float* gmB = GAM + (size_t)(pb1 >> 11) * NSLOT * 64 + (((pb1 & 2047) * 4) & 63);
            f32x4 SA = (f32x4){0.f, 0.f, 0.f, 0.f}, SB = SA, gA = SA, gB = SA; u32x2 kA = (u32x2){0u, 0u}, kB = kA;
            RwRaw raw = rw_load(P, WAG, b, h, dir, 0, t);
            rw_features(raw, mu, kkw, kaw, h, featb, t);
            raw = rw_load(P, WAG, b, h, dir, 1, t);
            __syncthreads();
#pragma unroll 1
            for (int hc = 0; hc < NHC; ++hc) {
                if (hc + 1 < NHC) rw_features(raw, mu, kkw, kaw, h, featb + ((hc + 1) & 1) * 12288, t);
                if (hc + 2 < NHC) raw = rw_load(P, WAG, b, h, dir, hc + 2, t);
                if (pb_on) { const int sl = hc >> 1;
                    if (!(hc & 1)) { kA = *(const u32x2*)(gsA + (size_t)sl * 8192); gA = *(const f32x4*)(gmA + sl * 64); kB = *(const u32x2*)(gsB + (size_t)sl * 8192); gB = *(const f32x4*)(gmB + sl * 64); }
                    else { u32x2 o; o.x = pk2(SA[0], SA[1]); o.y = pk2(SA[2], SA[3]); *(u32x2*)(gsA + (size_t)sl * 8192) = o; SA = gA * SA + (f32x4){bflo(kA.x), bfhi(kA.x), bflo(kA.y), bfhi(kA.y)};
                           o.x = pk2(SB[0], SB[1]); o.y = pk2(SB[2], SB[3]); *(u32x2*)(gsB + (size_t)sl * 8192) = o; SB = gB * SB + (f32x4){bflo(kB.x), bfhi(kB.x), bflo(kB.y), bfhi(kB.y)}; } }
                if (hc >= 9) { const int jj = t >> 3, q0 = 4 * (t & 7); const int R = rw_hrow(b, dir, hc - 1, jj); const LAS float* yb = ybufb + ((hc - 1) & 1) * 1024 + jj * 32 + q0;
                    u32x2 w; w.x = pk2(yb[0], yb[1]); w.y = pk2(yb[2], yb[3]); *(u32x2*)(Y + ((size_t)dir * ML + R) * 512 + h * 64 + 32 * half + q0) = w; }
                __syncthreads();
            }
            { const int hc = NHC; const int jj = t >> 3, q0 = 4 * (t & 7); const int R = rw_hrow(b, dir, hc - 1, jj); const LAS float* yb = ybufb + ((hc - 1) & 1) * 1024 + jj * 32 + q0;
              u32x2 w; w.x = pk2(yb[0], yb[1]); w.y = pk2(yb[2], yb[3]); *(u32x2*)(Y + ((size_t)dir * ML + R) * 512 + h * 64 + 32 * half + q0) = w; }
        } else {
            const int rr = lane >> 3, c = lane & 7, c8 = 8 * c, rowl = 8 * wave + rr, row = 32 * half + rowl;
            f32x2 S[4];
#pragma unroll
            for (int q = 0; q < 4; ++q) S[q] = (f32x2){0.f, 0.f};
            __syncthreads();
#pragma unroll 1
            for (int hc = 0; hc < NHC; ++hc) {
                const LAS float* fb = featb + (hc & 1) * 12288; LAS float* yb = ybufb + (hc & 1) * 1024;
                RwFeat f0 = rw_ldfeat(fb, c8, row);
                if (hc >= 8) {
#pragma unroll 1
                for (int j0 = 0; j0 < 32; j0 += 8) {
                    float ykeep = 0.f;
#pragma unroll
                    for (int u = 0; u < 8; ++u) {
                        const int jn = (j0 + u + 1) < 32 ? (j0 + u + 1) : 31;
                        const RwFeat f2 = rw_ldfeat(fb + jn * 384, c8, row);
                        __builtin_amdgcn_sched_barrier(0);
                        const float y = rw_step<true>(S, f0);
                        ykeep = (c == u) ? y : ykeep;
                        f0 = f2;
                    }
                    yb[(j0 + c) * 32 + rowl] = ykeep;
                    { f32x2 rho[4]; RW_LD2(rho, fb + (j0 + 7) * 384, 64)
#pragma unroll
                      for (int q = 0; q < 4; ++q) S[q] = S[q] * rho[q]; }
                }
                } else {
#pragma unroll 1
                for (int j0 = 0; j0 < 32; j0 += 8) {
                    float ykeep = 0.f;
#pragma unroll
                    for (int u = 0; u < 8; ++u) {
                        const int jn = (j0 + u + 1) < 32 ? (j0 + u + 1) : 31;
                        const RwFeat f2 = rw_ldfeat(fb + jn * 384, c8, row);
                        __builtin_amdgcn_sched_barrier(0);
                        const float y = rw_step<false>(S, f0);
                        ykeep = (c == u) ? y : ykeep;
                        f0 = f2;
                    }
                    yb[(j0 + c) * 32 + rowl] = ykeep;
                    { f32x2 rho[4]; RW_LD2(rho, fb + (j0 + 7) * 384, 64)
#pragma unroll
                      for (int q = 0; q < 4; ++q) S[q] = S[q] * rho[q]; }
                }
                }
                __syncthreads();
            }
        }
        __syncthreads();
    }
}
__device__ __forceinline__ void rwkv_assemble(const bf16* P, const bf16* WAG, const bf16* Y, const float* mu, const float* kaw, const float* rkw, const float* lnw, const float* lnb, bf16* Mx, int lane, int gw, int NGW) {
    for (int R = gw; R < ML; R += NGW) {
        const int c = 8 * lane; const Nb4 nb = neighbors(R);
        float r[8], k[8], v[8], a0[8], a1[8], g[8];
        { const Raw5 x = load_raw5(P, R, nb, c); xm8(x, mu + c, r); }
        { const Raw5 x = load_raw5(P, R, nb, PC_K + c); xm8(x, mu + PC_K + c, k); }
        { const Raw5 x = load_raw5(P, R, nb, PC_V + c); xm8(x, mu + PC_V + c, v); }
        unpack8(*(const u32x4*)(WAG + (size_t)R * NLO + 1024 + c), a0); unpack8(*(const u32x4*)(WAG + (size_t)R * NLO + 1536 + c), a1); unpack8(*(const u32x4*)(WAG + (size_t)R * NLO + 2048 + c), g);
        float y[8], yb[8]; unpack8(*(const u32x4*)(Y + (size_t)R * 512 + c), y); unpack8(*(const u32x4*)(Y + ((size_t)ML + R) * 512 + c), yb);
#pragma unroll
        for (int q = 0; q < 8; ++q) y[q] += yb[q];
        float s = 0.f;
#pragma unroll
        for (int q = 0; q < 8; ++q) s += y[q];
        const float mean = red8(s) * (1.f / 64.f); float sq = 0.f, bs = 0.f;
#pragma unroll
        for (int q = 0; q < 8; ++q) { const float d = y[q] - mean; sq += d * d; bs += r[q] * (k[q] * (2.0f + (a0[q] + a1[q] - 2.0f) * kaw[c + q])) * rkw[c + q]; }
        const float rstd = rsqrtf(red8(sq) * (1.f / 64.f) + 64e-5f); bs = red8(bs);
        float o[8];
#pragma unroll
        for (int q = 0; q < 8; ++q) o[q] = ((y[q] - mean) * rstd * lnw[c + q] + lnb[c + q] + bs * v[q]) * g[q];
        *(u32x4*)(Mx + (size_t)R * DM + c) = pack8(o);
    }
}
#define XB_TMO      128
#define XB_XCNT(j)  (256  + 64 * (j))
#define XB_XSUB(j)  (1280 + 64 * (j))
#define XB_XGEN(j)  (2304 + 64 * (j))
#define XB_TOP      3328
#define XB_TOPGEN   3392
#define XCD_BAR_WORDS 3456
#define XB_SPIN_CAP (1u << 18)

__device__ __forceinline__ unsigned xb_ld(unsigned* p)              { return __hip_atomic_load(p, __ATOMIC_RELAXED, __HIP_MEMORY_SCOPE_AGENT); }
__device__ __forceinline__ unsigned xb_add(unsigned* p, unsigned v) { return __hip_atomic_fetch_add(p, v, __ATOMIC_RELAXED, __HIP_MEMORY_SCOPE_AGENT); }
__device__ __forceinline__ unsigned xb_xcc_id() { return (unsigned)__builtin_amdgcn_s_getreg((3 << 11) | 20) & 0xFu; }
#define XB_SPIN(cond, bar) do { unsigned _sp = 0; while (cond) { __builtin_amdgcn_s_sleep(1); \
    if ((++_sp & 255u) == 0u) { if (xb_ld(&(bar)[XB_TMO])) break; if (_sp > XB_SPIN_CAP) { atomicAdd(&(bar)[XB_TMO], 1u); break; } } } } while (0)

struct XcdBarrier {
    unsigned* bar; unsigned x;
    volatile LAS unsigned* st;
};

__device__ __forceinline__ XcdBarrier xcd_barrier_post(unsigned* bar, volatile LAS unsigned* st) {
    XcdBarrier b; b.bar = bar; b.x = xb_xcc_id(); b.st = st;
    if (threadIdx.x == 0) (void)xb_add(&bar[XB_XCNT(b.x)], 1u);
    return b;
}
__device__ __forceinline__ void xcd_barrier_complete(unsigned* bar, unsigned x, unsigned& nloc, unsigned& nx) {
    const unsigned G = gridDim.x * gridDim.y * gridDim.z;
    unsigned sum, cnt, mine, sp = 0u;
    for (;;) {
        sum = 0u; cnt = 0u; mine = 0u;
#pragma unroll
        for (unsigned j = 0; j < 16; ++j) { const unsigned c = xb_ld(&bar[XB_XCNT(j)]); sum += c; cnt += (c > 0u) ? 1u : 0u; mine = (j == x) ? c : mine; }
        if (sum == G) break;
        __builtin_amdgcn_s_sleep(1);
        if ((++sp & 255u) == 0u) { if (xb_ld(&bar[XB_TMO])) break; if (sp > XB_SPIN_CAP) { atomicAdd(&bar[XB_TMO], 1u); break; } }
    }
    nloc = mine > 0u ? mine : 1u; nx = cnt > 0u ? cnt : 1u;
}

__device__ __forceinline__ void xcd_barrier(const XcdBarrier& b) {
    asm volatile("s_waitcnt vmcnt(0)" ::: "memory");
    __syncthreads();
    if (threadIdx.x == 0) {
        unsigned* bar = b.bar;
        __builtin_amdgcn_s_waitcnt(0);
        unsigned nloc = b.st[0], nx = b.st[1];
        if (nloc == 0u) { xcd_barrier_complete(bar, b.x, nloc, nx); b.st[0] = nloc; b.st[1] = nx; }
        const unsigned old = xb_add(&bar[XB_XSUB(b.x)], 1u);
        const unsigned gen = old / nloc;
        if (old + 1u == (gen + 1u) * nloc) {
            __builtin_amdgcn_fence(__ATOMIC_RELEASE, "agent");
            asm volatile("s_waitcnt vmcnt(0)" ::: "memory");
            const unsigned og = xb_add(&bar[XB_TOP], 1u);
            const unsigned tg = og / nx;
            if (og + 1u == (tg + 1u) * nx) xb_add(&bar[XB_TOPGEN], 1u);
            else XB_SPIN(xb_ld(&bar[XB_TOPGEN]) == tg, bar);
            __builtin_amdgcn_fence(__ATOMIC_ACQUIRE, "agent");
            xb_add(&bar[XB_XGEN(b.x)], 1u);
            asm volatile("s_waitcnt vmcnt(0)" ::: "memory");
        } else {
            XB_SPIN(xb_ld(&bar[XB_XGEN(b.x)]) == gen, bar);
            __builtin_amdgcn_fence(__ATOMIC_ACQUIRE, "agent");
            asm volatile("s_waitcnt vmcnt(0)" ::: "memory");
        }
    }
    __syncthreads();
}

__global__ void __launch_bounds__(512, 2) mega_fwd(Args a) {
    extern __shared__ __attribute__((aligned(16))) unsigned char lds_raw[];
    LAS unsigned char* lds = (LAS unsigned char*)lds_raw;
    cg::grid_group grid = cg::this_grid();
#define GSYNC() do { asm volatile("s_waitcnt vmcnt(0)" ::: "memory"); grid.sync(); } while (0)
    volatile LAS unsigned* bst = (volatile LAS unsigned*)(lds + LDS_BYTES - 64);
    if (threadIdx.x < 2) bst[threadIdx.x] = 0u;
    __syncthreads();
    const XcdBarrier xbar = xcd_barrier_post((unsigned*)a.ws, bst);
#define XSYNC() xcd_barrier(xbar)
    const int tid = threadIdx.x, lane = tid & 63, wave = __builtin_amdgcn_readfirstlane(tid >> 6);
    const int G = gridDim.x, bx = blockIdx.x, gw = bx * 8 + wave, NGW = G * 8;
    unsigned char* ws = a.ws;
    bf16* P = (bf16*)(ws + WS_P); bf16* XN = (bf16*)(ws + WS_XN); bf16* WAG = (bf16*)(ws + WS_WAG); bf16* GS = (bf16*)(ws + WS_GS); float* GAM = (float*)(ws + WS_GAM);
    float* mod = (float*)(ws + WS_MOD); bf16* Y = (bf16*)a.out; bf16* LA = (bf16*)((unsigned char*)a.out + 64 * MiB); bf16* Mx = LA;
    bf16* H = (bf16*)(ws + WS_H); bf16* H2 = (bf16*)(ws + WS_H2);   bf16* XN2 = (bf16*)(ws + WS_XN2); bf16* HMID = (bf16*)(ws + WS_HMID);
    const float* mu = a.in[8];

    phase0(a, lds, tid, lane, wave);
    if (a.ws == nullptr) GSYNC();
    XSYNC();
#if defined(STOP_AFTER)
    if (STOP_AFTER == 1) return;
#endif
    for (int R = gw; R < MT; R += 2 * NGW) {
        const int R2 = R + NGW; const bool two = R2 < MT;
        const float* src = R < ML ? a.in[0] + (size_t)R * DM : a.in[2] + (size_t)(R - ML) * DM; const float* mrow = mod + (size_t)(R < ML ? (R >> 12) : 8) * MODN;
        const NormRow r0 = norm_load(src, lane);
        if (two) { const float* src2 = R2 < ML ? a.in[0] + (size_t)R2 * DM : a.in[2] + (size_t)(R2 - ML) * DM; const float* mrow2 = mod + (size_t)(R2 < ML ? (R2 >> 12) : 8) * MODN;
            const NormRow r1 = norm_load(src2, lane);
            norm_finish<0>(r0, a.in[6], mrow, mrow + 1024, XN + (size_t)R * DM, lane);
            norm_finish<0>(r1, a.in[6], mrow2, mrow2 + 1024, XN + (size_t)R2 * DM, lane); }
        else norm_finish<0>(r0, a.in[6], mrow, mrow + 1024, XN + (size_t)R * DM, lane);
    }
    XSYNC();
#if defined(STOP_AFTER)
    if (STOP_AFTER == 2) return;
#endif
    { pg8::Gemm g{XN, (const bf16*)(ws + WS_WIN), MT, NINP, DM}; asm volatile("" : "+s"(g.K)); pg8::StaticOrder S; S.init(MT, NINP, G, bx);
      pg8::EpiBf16<0> E{P, NINP, nullptr, 0, 0, 1.f};
      pg8::gemm_phase<pg8::EpiBf16<0>, pg8::StaticOrder, true, true>(lds, g, S, E); }
    XSYNC();
#if defined(STOP_AFTER)
    if (STOP_AFTER == 3) return;
#endif
    phase_la(P, mu, LA, lane, gw, NGW);
    gla_pass_a(P, a.in[19], a.in[20], GS, GAM, lds, tid, lane, wave);
    XSYNC();
#if defined(STOP_AFTER)
    if (STOP_AFTER == 4) return;
#endif
    if (G != 256) gla_pass_b(GS, GAM, tid);
    { pg8::Gemm g{LA, (const bf16*)(ws + WS_WLORA), MT, NLO, KLB, KLO, 128, 256}; asm volatile("" : "+s"(g.K)); pg8::StaticOrder S; S.init(MT, NLO, G, bx);
      pg8::EpiLora E{WAG, NLO, a.in[9], a.in[11]};
      pg8::gemm_phase<pg8::EpiLora, pg8::StaticOrder, true, true>(lds, g, S, E); }
    XSYNC();
#if defined(STOP_AFTER)
    if (STOP_AFTER == 5) return;
#endif
    rwkv_scan(P, WAG, mu, a.in[14], a.in[15], Y, lds, tid, lane, wave, GS, GAM);
    XSYNC();
#if defined(STOP_AFTER)
    if (STOP_AFTER == 6) return;
#endif
    { const AsmCtx AC{P, WAG, Y, mu, a.in[15], a.in[16], a.in[17], a.in[18], Mx};
      gla_pass_c(P, a.in[19], a.in[20], a.in[21], GS, Mx, lds, tid, lane, wave, AC, gw, NGW); }
    XSYNC();
#if defined(STOP_AFTER)
    if (STOP_AFTER == 7) return;
#endif
    { pg8::Gemm g{Mx, (const bf16*)(ws + WS_WOUT), ML, DM, DM}; asm volatile("" : "+s"(g.K)); pg8::StaticOrder S; S.init(ML, DM, G, bx);
      pg8::EpiGateRes<false, true> E{a.in[0], mod + 2048, H, DM, MODN};
      pg8::gemm_phase<pg8::EpiGateRes<false, true>, pg8::StaticOrder, true, true>(lds, g, S, E); }
    XSYNC();
#if defined(STOP_AFTER)
    if (STOP_AFTER == 8) return;
#endif
    for (int R = gw; R < ML; R += 2 * NGW) { const int R2r = R + NGW; const bool two8 = R2r < ML; const int R2 = two8 ? R2r : R;
        const float* mrow = mod + (size_t)(R >> 12) * MODN; const float* mrow2 = mod + (size_t)(R2 >> 12) * MODN;
        const NormRowB r0 = normb_load(H + (size_t)R * DM, lane), r1 = normb_load(H + (size_t)R2 * DM, lane);
        normb_finish(r0, a.in[23], mrow + 3072, mrow + 4096, XN2 + (size_t)R * DM, lane);
        if (two8) normb_finish(r1, a.in[23], mrow2 + 3072, mrow2 + 4096, XN2 + (size_t)R2 * DM, lane); }
    XSYNC();
#if defined(STOP_AFTER)
    if (STOP_AFTER == 9) return;
#endif
    { pg8::Gemm g{XN2, (const bf16*)(ws + WS_WFFI), ML, 2 * FF, DM}; asm volatile("" : "+s"(g.K)); pg8::StaticOrder S; S.init(ML, 2 * FF, G, bx);
      pg8::EpiSwiglu E{HMID, FF};
      pg8::gemm_phase<pg8::EpiSwiglu, pg8::StaticOrder, true, true>(lds, g, S, E); }
    XSYNC();
#if defined(STOP_AFTER)
    if (STOP_AFTER == 10) return;
#endif
    { pg8::Gemm g{HMID, (const bf16*)(ws + WS_WFFO), ML, DM, FF}; asm volatile("" : "+s"(g.K)); pg8::StaticOrder S; S.init(ML, DM, G, bx);
      pg8::EpiGateRes<true, true> E{H, mod + 5120, H2, DM, MODN};
      pg8::gemm_phase<pg8::EpiGateRes<true, true>, pg8::StaticOrder, true, true>(lds, g, S, E); }
    XSYNC();
#if defined(STOP_AFTER)
    if (STOP_AFTER == 11) return;
#endif
    for (int R = gw; R < ML; R += 2 * NGW) { const int R2r = R + NGW; const bool two11 = R2r < ML; const int R2 = two11 ? R2r : R;
        const NormRowB r0 = normb_load(H2 + (size_t)R * DM, lane), r1 = normb_load(H2 + (size_t)R2 * DM, lane);
        normb_final(r0, a.in[26], a.out + (size_t)R * DM, lane);
        if (two11) normb_final(r1, a.in[26], a.out + (size_t)R2 * DM, lane); }
}

extern "C" void kernel_launch(void* const* d_in, const int* in_sizes, int n_in, void* d_out, int out_size, void* d_ws, size_t ws_size, hipStream_t stream) {
    static int grid = 0;
    if (grid == 0) {
        if (n_in != 27 || out_size != ML * DM || ws_size < WS_END) { fprintf(stderr, "kernel_launch: unexpected shapes (n_in %d out %d ws %zu)\n", n_in, out_size, ws_size); grid = -1; return; }
        int dev = 0, cus = 0, per_cu = 0;
        hipGetDevice(&dev); hipDeviceGetAttribute(&cus, hipDeviceAttributeMultiprocessorCount, dev);
        if (hipFuncSetAttribute((const void*)mega_fwd, hipFuncAttributeMaxDynamicSharedMemorySize, LDS_BYTES) != hipSuccess) { fprintf(stderr, "kernel_launch: hipFuncSetAttribute failed\n"); grid = -1; return; }
        hipOccupancyMaxActiveBlocksPerMultiprocessor(&per_cu, (const void*)mega_fwd, 512, LDS_BYTES);
        (void)hipGetLastError();
        if (per_cu < 1) { fprintf(stderr, "kernel_launch: occupancy query says %d blocks per CU\n", per_cu); per_cu = 1; }
        grid = cus;
    }
    if (grid < 0) return;
    if (hipMemsetAsync(d_ws, 0, 16384, stream) != hipSuccess) { fprintf(stderr, "kernel_launch: memset failed\n"); return; }
    Args a{};
    for (int i = 0; i < 27; ++i) a.in[i] = (const float*)d_in[i];
    a.out = (float*)d_out; a.ws = (unsigned char*)d_ws;
    void* args[] = {&a};
    hipError_t e = hipLaunchCooperativeKernel((const void*)mega_fwd, dim3(grid), dim3(512), args, LDS_BYTES, stream);
    if (e != hipSuccess) fprintf(stderr, "cooperative launch failed: %s (grid %d)\n", hipGetErrorString(e), grid);
}
```
